# Optimizing an MI355X kernel written in HIP

```python
import jax, jax.numpy as jnp
from jax import lax
import numpy as np

D_MODEL = 1024
BATCH = 4
SEQ = 4096
DEPTH = 1
DEC_BATCH = 32
DEC_SEQ = 1
PAST_LEN = 16384
PAGE_SIZE = 128

HEAD_DIM = 64
ROPE_DIM = HEAD_DIM // 4
ROPE_THETA = 500000.0
DSWA_GROUPS = ((128, 1), (512, 4), (2048, 16))
HEADS_PER_GROUP = 4
N_GROUPS = len(DSWA_GROUPS)
A_HEADS = N_GROUPS * HEADS_PER_GROUP
A_QKV = A_HEADS * HEAD_DIM
A_OUT = HEADS_PER_GROUP * HEAD_DIM
BAND = 128
M_HEADS = 4
M_INNER = D_MODEL
M_DK = M_INNER // M_HEADS
M_DV = M_INNER // M_HEADS
CONV_W = 4
M_CHUNK = 64
D_FF = -(-(8 * D_MODEL) // (3 * 256)) * 256
PLE_DIM = 256
EPS = 1e-6
NEG = -1e30

OFF_AQ = 0
OFF_AK = OFF_AQ + A_QKV
OFF_AV = OFF_AK + A_QKV
OFF_MQ = OFF_AV + A_QKV
OFF_MK = OFF_MQ + M_INNER
OFF_MV = OFF_MK + M_INNER
OFF_MO = OFF_MV + M_INNER
OFF_MI = OFF_MO + M_INNER
OFF_MF = OFF_MI + M_HEADS
OFF_GA = OFF_MF + M_HEADS
OFF_GB = OFF_GA + D_MODEL
IN_COLS = OFF_GB + D_MODEL

kernel_name = 'dilated_swa_mlstm_hybrid_step'


def _rmsnorm(x, g):
    xf = x.astype(jnp.float32)
    y = xf * lax.rsqrt(jnp.mean(xf * xf, axis=-1, keepdims=True) + EPS)
    return (y * g.astype(jnp.float32)).astype(x.dtype)


def _rope(x, pos):
    half = ROPE_DIM // 2
    inv = jnp.power(ROPE_THETA, -jnp.arange(half, dtype=jnp.float32) / half)
    ang = pos.astype(jnp.float32)[:, None] * inv[None, :]
    cos = jnp.cos(ang)[None, :, None, :]
    sin = jnp.sin(ang)[None, :, None, :]
    xf = x.astype(jnp.float32)
    x1, x2, rest = xf[..., :half], xf[..., half:ROPE_DIM], xf[..., ROPE_DIM:]
    out = jnp.concatenate([x1 * cos - x2 * sin, x2 * cos + x1 * sin, rest], axis=-1)
    return out.astype(x.dtype)


def _dilated_attn_prompt(q, k, v, dil):
    B, S, H, D = q.shape
    span = dil * BAND
    s_pad = -(-S // span) * span
    nsub = s_pad // dil
    nb = nsub // BAND

    def to_blocks(t):
        t = jnp.pad(t.astype(jnp.float32), ((0, 0), (0, s_pad - S), (0, 0), (0, 0)))
        t = t.reshape(B, nsub, dil, H, D).transpose(0, 2, 1, 3, 4)
        return t.reshape(B, dil, nb, BAND, H, D)

    def with_prev(t):
        prev = jnp.pad(t, ((0, 0), (0, 0), (1, 0), (0, 0), (0, 0), (0, 0)))[:, :, :-1]
        return jnp.concatenate([prev, t], axis=3)

    qb, kb, vb = to_blocks(q), to_blocks(k), to_blocks(v)
    kk, vv = with_prev(kb), with_prev(vb)
    s = jnp.einsum('brnqhd,brnkhd->brnhqk', qb, kk) * (HEAD_DIM ** -0.5)
    qi = jnp.arange(BAND)[:, None]
    kj = jnp.arange(2 * BAND)[None, :]
    dist = BAND + qi - kj
    blk = jnp.arange(nb)[:, None, None]
    valid = (dist >= 0) & (dist <= BAND) & ((blk > 0) | (kj >= BAND))
    s = jnp.where(valid[None, None, :, None], s, -jnp.inf)
    mx = jnp.max(s, axis=-1, keepdims=True)
    e = jnp.exp(s - mx)
    den = jnp.sum(e, axis=-1, keepdims=True)
    o = jnp.einsum('brnhqk,brnkhd->brnqhd', e / den, vv)
    lse = (mx + jnp.log(den))[..., 0]
    o = o.reshape(B, dil, nsub, H, D).transpose(0, 2, 1, 3, 4).reshape(B, s_pad, H, D)[:, :S]
    lse = lse.transpose(0, 1, 2, 4, 3).reshape(B, dil, nsub, H).transpose(0, 2, 1, 3).reshape(B, s_pad, H)[:, :S]
    return o, lse


def _dilated_attn_gather(q, k_ext, v_ext, dil, past):
    B, T, H, D = q.shape
    idx = past + jnp.arange(T)[:, None] - dil * jnp.arange(BAND + 1)[None, :]
    valid = idx >= 0
    flat = jnp.maximum(idx, 0).reshape(-1)
    kg = jnp.take(k_ext, flat, axis=1).reshape(B, T, BAND + 1, H, D).astype(jnp.float32)
    vg = jnp.take(v_ext, flat, axis=1).reshape(B, T, BAND + 1, H, D).astype(jnp.float32)
    s = jnp.einsum('bthd,btkhd->bthk', q.astype(jnp.float32), kg) * (HEAD_DIM ** -0.5)
    s = jnp.where(valid[None, :, None, :], s, -jnp.inf)
    mx = jnp.max(s, axis=-1, keepdims=True)
    e = jnp.exp(s - mx)
    den = jnp.sum(e, axis=-1, keepdims=True)
    o = jnp.einsum('bthk,btkhd->bthd', e / den, vg)
    lse = (mx + jnp.log(den))[..., 0]
    return o, lse


def _causal_conv(x, buf, w, b):
    T = x.shape[1]
    xp = jnp.concatenate([buf.astype(x.dtype), x], axis=1)
    y = b + w[0] * xp[:, 0:T]
    for j in range(1, CONV_W):
        y = y + w[j] * xp[:, j:j + T]
    return y, xp[:, T:]


def _mlstm(q, k, v, ig, lf, C0, n0, m0):
    B, T, H, DK = q.shape
    DV = v.shape[-1]
    L = min(M_CHUNK, T)
    nc = -(-T // L)
    pad = nc * L - T
    f32 = jnp.float32

    def chunks(t, fill):
        t = jnp.pad(t.astype(f32), ((0, 0), (0, pad)) + ((0, 0),) * (t.ndim - 2), constant_values=fill)
        t = t.reshape((B, nc, L) + t.shape[2:])
        return jnp.moveaxis(jnp.moveaxis(t, 1, 0), 2, 3)

    xs = (chunks(q, 0.0), chunks(k, 0.0), chunks(v, 0.0), chunks(ig, NEG), chunks(lf, 0.0))
    tril = jnp.tril(jnp.ones((L, L), dtype=bool))

    def step(carry, xc):
        C, n, m = carry
        qc, kc, vc, ic, fc = xc
        b = jnp.cumsum(fc, axis=-1)
        dmat = jnp.where(tril, b[..., :, None] - b[..., None, :] + ic[..., None, :], -jnp.inf)
        m_inter = b + m[..., None]
        m_t = jnp.maximum(m_inter, jnp.max(dmat, axis=-1))
        w_intra = jnp.einsum('bhtd,bhsd->bhts', qc, kc) * jnp.exp(dmat - m_t[..., None])
        w_inter = jnp.exp(m_inter - m_t)
        num = jnp.einsum('bhts,bhsv->bhtv', w_intra, vc) + w_inter[..., None] * jnp.einsum('bhtd,bhdv->bhtv', qc, C)
        den = jnp.sum(w_intra, axis=-1) + w_inter * jnp.einsum('bhtd,bhd->bht', qc, n)
        h = num / jnp.maximum(jnp.abs(den), jnp.exp(-m_t))[..., None]
        b_last = b[..., -1]
        g = b_last[..., None] - b + ic
        m_new = jnp.maximum(b_last + m, jnp.max(g, axis=-1))
        wk = jnp.exp(g - m_new[..., None])
        decay = jnp.exp(b_last + m - m_new)
        C_new = decay[..., None, None] * C + jnp.einsum('bhs,bhsd,bhsv->bhdv', wk, kc, vc)
        n_new = decay[..., None] * n + jnp.einsum('bhs,bhsd->bhd', wk, kc)
        return (C_new, n_new, m_new), h

    (C1, n1, m1), hs = lax.scan(step, (C0.astype(f32), n0.astype(f32), m0.astype(f32)), xs)
    h = jnp.moveaxis(hs, 0, 1)
    h = jnp.swapaxes(h, 2, 3).reshape(B, nc * L, H, DV)[:, :T]
    return h, C1, n1, m1


def _layer(h, p, pos0, kv_bufs, conv_buf, C0, n0, m0, norm_mix, w_in, conv_w, conv_b, b_igate, b_fgate, mh_norm, w_proj_a, w_proj_b, w_out, norm_ffn, w_gate, w_up, w_down, norm_ple, w_ple_gate, w_ple_proj):
    B, T, _ = h.shape
    f32 = jnp.float32
    xn = _rmsnorm(h, norm_mix)
    z = xn @ w_in
    pos = pos0 + jnp.arange(T, dtype=jnp.int32)

    qa = _rope(z[..., OFF_AQ:OFF_AK].reshape(B, T, A_HEADS, HEAD_DIM), pos)
    ka = _rope(z[..., OFF_AK:OFF_AV].reshape(B, T, A_HEADS, HEAD_DIM), pos)
    va = z[..., OFF_AV:OFF_MQ].reshape(B, T, A_HEADS, HEAD_DIM)
    outs, lses, new_kv = [], [], []
    for g, (win, dil) in enumerate(DSWA_GROUPS):
        sl = slice(g * HEADS_PER_GROUP, (g + 1) * HEADS_PER_GROUP)
        kv_new = jnp.stack([ka[:, :, sl], va[:, :, sl]], axis=2)
        if kv_bufs is None:
            o, lse = _dilated_attn_prompt(qa[:, :, sl], ka[:, :, sl], va[:, :, sl], dil)
            ext = kv_new
        else:
            past = kv_bufs[g].shape[1]
            ext = jnp.concatenate([kv_bufs[g].astype(kv_new.dtype), kv_new], axis=1)
            o, lse = _dilated_attn_gather(qa[:, :, sl], ext[:, :, 0], ext[:, :, 1], dil, past)
        outs.append(o)
        lses.append(lse)
        keep = min(win, ext.shape[1])
        new_kv.append(ext[:, ext.shape[1] - keep:])
    wgt = jax.nn.softmax(jnp.stack(lses, axis=0), axis=0)
    o_a = jnp.einsum('gbth,gbthd->bthd', wgt, jnp.stack(outs, axis=0))
    o_a = o_a.reshape(B, T, A_OUT).astype(h.dtype)

    qk, conv_new = _causal_conv(z[..., OFF_MQ:OFF_MV], conv_buf, conv_w, conv_b)
    qk = jax.nn.silu(qk)
    qm = qk[..., :M_INNER].reshape(B, T, M_HEADS, M_DK)
    km = qk[..., M_INNER:].reshape(B, T, M_HEADS, M_DK) * (M_DK ** -0.5)
    vm = z[..., OFF_MV:OFF_MO].reshape(B, T, M_HEADS, M_DV)
    og = jax.nn.sigmoid(z[..., OFF_MO:OFF_MI])
    ig = z[..., OFF_MI:OFF_MF].astype(f32) + b_igate.astype(f32)
    lf = jax.nn.log_sigmoid(z[..., OFF_MF:OFF_GA].astype(f32) + b_fgate.astype(f32))
    hm, C1, n1, m1 = _mlstm(qm, km, vm, ig, lf, C0, n0, m0)
    hm = hm * lax.rsqrt(jnp.mean(hm * hm, axis=-1, keepdims=True) + EPS) * mh_norm.astype(f32)
    o_b = hm.reshape(B, T, M_INNER).astype(h.dtype) * og

    ga = jax.nn.sigmoid(z[..., OFF_GA:OFF_GB])
    gb = jax.nn.sigmoid(z[..., OFF_GB:IN_COLS])
    mix = ga * (o_a @ w_proj_a) + gb * (o_b @ w_proj_b)
    h = h + mix @ w_out

    xf = _rmsnorm(h, norm_ffn)
    h = h + (jax.nn.silu(xf @ w_gate) * (xf @ w_up)) @ w_down

    xp = _rmsnorm(h, norm_ple)
    h = h + jax.nn.sigmoid(xp @ w_ple_gate) * (p.astype(h.dtype) @ w_ple_proj)
    return h, (new_kv[0], new_kv[1], new_kv[2], conv_new, C1.astype(C0.dtype), n1.astype(n0.dtype), m1.astype(m0.dtype))


def setup_inputs(seed: int = 0) -> dict:
    key = jax.random.key(seed)
    k = jax.random.split(key, 29)
    f32 = jnp.float32

    def nrm(i, shape, scale=1.0):
        return jax.random.normal(k[i], shape, f32) * scale

    def gain(i, shape):
        return 1.0 + 0.02 * jax.random.normal(k[i], shape, f32)

    win_len = [min(w, PAST_LEN) for w, _ in DSWA_GROUPS]

    def kv_shape(n):
        return (DEPTH, DEC_BATCH, n, 2, HEADS_PER_GROUP, HEAD_DIM)

    return {
        'x_prompt': nrm(0, (BATCH, SEQ, D_MODEL)),
        'x_sample': nrm(1, (DEC_BATCH, DEC_SEQ, D_MODEL)),
        'cache_kv_w128': nrm(2, kv_shape(win_len[0])),
        'cache_kv_w512': nrm(3, kv_shape(win_len[1])),
        'cache_kv_w2048': nrm(4, kv_shape(win_len[2])),
        'state_conv': nrm(5, (DEPTH, DEC_BATCH, CONV_W - 1, 2 * M_INNER)),
        'state_C': nrm(6, (DEPTH, DEC_BATCH, M_HEADS, M_DK, M_DV), M_DK ** -0.5),
        'state_n': nrm(7, (DEPTH, DEC_BATCH, M_HEADS, M_DK), M_DK ** -0.5),
        'state_m': nrm(8, (DEPTH, DEC_BATCH, M_HEADS)),
        'p_prompt': nrm(9, (DEPTH, BATCH, SEQ, PLE_DIM)),
        'p_sample': nrm(10, (DEPTH, DEC_BATCH, DEC_SEQ, PLE_DIM)),
        'norm_mix': gain(11, (DEPTH, D_MODEL)),
        'w_in': nrm(12, (DEPTH, D_MODEL, IN_COLS), D_MODEL ** -0.5),
        'conv_w': nrm(13, (DEPTH, CONV_W, 2 * M_INNER), CONV_W ** -0.5),
        'conv_b': nrm(14, (DEPTH, 2 * M_INNER), 0.02),
        'b_igate': nrm(15, (DEPTH, M_HEADS), 0.1),
        'b_fgate': jnp.linspace(3.0, 6.0, M_HEADS, dtype=f32)[None, :] + nrm(16, (DEPTH, M_HEADS), 0.1),
        'mh_norm': gain(17, (DEPTH, M_HEADS, M_DV)),
        'w_proj_a': nrm(18, (DEPTH, A_OUT, D_MODEL), A_OUT ** -0.5),
        'w_proj_b': nrm(19, (DEPTH, M_INNER, D_MODEL), M_INNER ** -0.5),
        'w_out': nrm(20, (DEPTH, D_MODEL, D_MODEL), D_MODEL ** -0.5),
        'norm_ffn': gain(21, (DEPTH, D_MODEL)),
        'w_gate': nrm(22, (DEPTH, D_MODEL, D_FF), D_MODEL ** -0.5),
        'w_up': nrm(23, (DEPTH, D_MODEL, D_FF), D_MODEL ** -0.5),
        'w_down': nrm(24, (DEPTH, D_FF, D_MODEL), D_FF ** -0.5),
        'norm_ple': gain(25, (DEPTH, D_MODEL)),
        'w_ple_gate': nrm(26, (DEPTH, D_MODEL, D_MODEL), D_MODEL ** -0.5),
        'w_ple_proj': nrm(27, (DEPTH, PLE_DIM, D_MODEL), PLE_DIM ** -0.5),
        'norm_final': gain(28, (D_MODEL,)),
    }


def reference(x_prompt, x_sample, cache_kv_w128, cache_kv_w512, cache_kv_w2048, state_conv, state_C, state_n, state_m, p_prompt, p_sample, norm_mix, w_in, conv_w, conv_b, b_igate, b_fgate, mh_norm, w_proj_a, w_proj_b, w_out, norm_ffn, w_gate, w_up, w_down, norm_ple, w_ple_gate, w_ple_proj, norm_final):
    caches = (cache_kv_w128, cache_kv_w512, cache_kv_w2048)
    bp = x_prompt.shape[0]
    hp, hs = x_prompt, x_sample
    st_p, st_s = [], []
    for l in range(DEPTH):
        lw = (norm_mix[l], w_in[l], conv_w[l], conv_b[l], b_igate[l], b_fgate[l], mh_norm[l],
              w_proj_a[l], w_proj_b[l], w_out[l], norm_ffn[l], w_gate[l], w_up[l], w_down[l],
              norm_ple[l], w_ple_gate[l], w_ple_proj[l])
        zc = jnp.zeros((bp, CONV_W - 1, 2 * M_INNER), x_prompt.dtype)
        zC = jnp.zeros((bp, M_HEADS, M_DK, M_DV), state_C.dtype)
        zn = jnp.zeros((bp, M_HEADS, M_DK), state_n.dtype)
        zm = jnp.zeros((bp, M_HEADS), state_m.dtype)
        hp, sp = _layer(hp, p_prompt[l], 0, None, zc, zC, zn, zm, *lw)
        hs, ss = _layer(hs, p_sample[l], PAST_LEN, (caches[0][l], caches[1][l], caches[2][l]),
                        state_conv[l], state_C[l], state_n[l], state_m[l], *lw)
        st_p.append(sp)
        st_s.append(ss)

    def stk(i, sts):
        return jnp.stack([s[i] for s in sts], axis=0)

    y_prompt = _rmsnorm(hp, norm_final)
    y_sample = _rmsnorm(hs, norm_final)
    return (y_prompt, y_sample, stk(0, st_p), stk(0, st_s), stk(1, st_p), stk(1, st_s), stk(2, st_p), stk(2, st_s), stk(3, st_p), stk(3, st_s), stk(4, st_p), stk(4, st_s), stk(5, st_p), stk(5, st_s), stk(6, st_p), stk(6, st_s))
```

```cpp
#include <hip/hip_runtime.h>
#include <hip/hip_cooperative_groups.h>
#include <cstdio>
#include <cstdint>
namespace cg = cooperative_groups;
#define REP_SYNC 1
#define REP_P0 1
#define REP_P1 1
#define REP_P2A 1
#define REP_P2B 1
#define REP_ML 1
#define REP_CP 1
#define REP_VT 1
#define REP_EPZ 1
#define REP_SA 1
#define REP_AT 1
#define REP_CV 1
#define REP_E2 1
#define REP_P3 1
#define REP_P4 1
#define REP_P5 1
#define REP_P8 1

constexpr int MP = 16384, MS = 32, MT = MP + MS, MPAD = 16640;
constexpr int DM = 1024, SEQ = 4096, NZ = 8448, DFF = 2816, NGU = 2 * DFF, KMIX = 1280;
constexpr int ZQ = 0, ZK = 768, ZV = 1536, ZMQ = 2304, ZMK = 3328, ZMV = 4352, ZMO = 5376, ZGA = 6400, ZGB = 7424;
constexpr float EPSN = 1e-6f;
constexpr float LOG2E = 1.4426950408889634f, LN2 = 0.6931471805599453f;
constexpr float QSCALE = 0.125f * LOG2E;

constexpr size_t O_Y_P = 0, O_Y_S = O_Y_P + (size_t)MP * DM, O_KV128_P = O_Y_S + (size_t)MS * DM, O_KV128_S = O_KV128_P + 4 * 128 * 512,
                 O_KV512_P = O_KV128_S + 32 * 128 * 512, O_KV512_S = O_KV512_P + 4 * 512 * 512, O_KV2048_P = O_KV512_S + 32 * 512 * 512,
                 O_KV2048_S = O_KV2048_P + 4 * 2048 * 512, O_CONV_P = O_KV2048_S + (size_t)32 * 2048 * 512, O_CONV_S = O_CONV_P + 4 * 3 * 2048,
                 O_C_P = O_CONV_S + 32 * 3 * 2048, O_C_S = O_C_P + 16 * 65536, O_N_P = O_C_S + 128 * 65536, O_N_S = O_N_P + 16 * 256,
                 O_M_P = O_N_S + 128 * 256, O_M_S = O_M_P + 16, O_END = O_M_S + 128;

constexpr size_t al256(size_t x) { return (x + 255) & ~(size_t)255; }
constexpr size_t WS_WIN = 0;
constexpr size_t WS_WA = WS_WIN + (size_t)NZ * DM * 2;
constexpr size_t WS_WB = WS_WA + (size_t)DM * 256 * 2;
constexpr size_t WS_WO = WS_WB + (size_t)DM * DM * 2;
constexpr size_t WS_WGU = WS_WO + (size_t)DM * DM * 2;
constexpr size_t WS_WD = WS_WGU + (size_t)NGU * DM * 2;
constexpr size_t WS_WPG = WS_WD + (size_t)DM * DFF * 2;
constexpr size_t WS_WPP = WS_WPG + (size_t)DM * DM * 2;
constexpr size_t WS_GATES = WS_WPP + (size_t)DM * 256 * 2;
constexpr size_t WS_ROPE = al256(WS_GATES + (size_t)MT * 8 * 4);
constexpr size_t WS_PB = al256(WS_ROPE + (size_t)4097 * 16 * 4);
constexpr size_t WS_LSE = WS_PB + (size_t)MPAD * 256 * 2;
constexpr size_t WS_SSQ = WS_LSE + (size_t)3 * MPAD * 4 * 4;
constexpr size_t WS_SS1 = WS_SSQ + (size_t)MP * 64 * 4;
constexpr size_t WS_SS2 = WS_SS1 + (size_t)MPAD * 16 * 4;
constexpr size_t WS_SS3 = WS_SS2 + (size_t)MPAD * 16 * 4;
constexpr size_t WS_SOB = WS_SS3 + (size_t)MPAD * 16 * 4;
constexpr size_t WS_BAR = WS_SOB + (size_t)32 * 1024 * 2;
constexpr size_t WS_GS = WS_BAR + 16384;
constexpr size_t WS_XN = WS_GS + (size_t)16 * 4096 * 16;
constexpr size_t WS_VT = WS_XN + (size_t)MPAD * DM * 2;
constexpr size_t WS_OG = WS_VT + (size_t)4 * 12 * 64 * 4096 * 2;
constexpr size_t WS_QK = WS_OG + (size_t)3 * MPAD * 256 * 2;
constexpr size_t WS_HBUF = WS_QK + (size_t)MP * 2048 * 2;
constexpr size_t WS_Z = WS_HBUF + (size_t)MPAD * DM * 2;
constexpr size_t WS_HF = WS_Z;
constexpr size_t WS_ACT = WS_HF + (size_t)MPAD * DM * 4;
constexpr size_t WS_PP = WS_ACT + (size_t)MPAD * DFF * 2;
constexpr size_t WS_END = WS_Z + (size_t)MPAD * NZ * 2;
static_assert(WS_PP + (size_t)MPAD * DM * 4 <= WS_END, "overlay fits in z");
static_assert((size_t)MPAD * KMIX * 2 <= (size_t)MP * 2048 * 2, "o_ab fits in qk");
static_assert((size_t)MPAD * DM * 2 <= (size_t)(WS_QK - WS_VT), "mixA fits in vt|og");
static_assert(WS_END <= (size_t)512 * 1024 * 1024, "workspace");

constexpr int LDS_BYTES = 140 * 1024;
#define LAS __attribute__((address_space(3)))
typedef unsigned short bf16;
typedef float f32x4v __attribute__((ext_vector_type(4)));
typedef float f32x2v __attribute__((ext_vector_type(2)));
typedef unsigned u32x4v __attribute__((ext_vector_type(4)));
typedef unsigned u32x2v __attribute__((ext_vector_type(2)));
typedef short s16x8v __attribute__((ext_vector_type(8)));

__device__ __forceinline__ unsigned f2bf(float f) { unsigned u = __builtin_bit_cast(unsigned, f); return (u + 0x7fffu + ((u >> 16) & 1u)) >> 16; }
typedef __bf16 bf16x2_hw __attribute__((ext_vector_type(2)));
__device__ __forceinline__ unsigned pk2(float lo, float hi) { const f32x2v v = {lo, hi}; return __builtin_bit_cast(unsigned, __builtin_convertvector(v, bf16x2_hw)); }
__device__ __forceinline__ float sum_x16(float v) { return v + __shfl_xor(v, 16); }
__device__ __forceinline__ float sum_x32(float v) { return v + __shfl_xor(v, 32); }
__device__ __forceinline__ float max_x32(float v) { return fmaxf(v, __shfl_xor(v, 32)); }
__device__ __forceinline__ float sum_grp8(float v) {
    v += __builtin_bit_cast(float, __builtin_amdgcn_update_dpp(0, __builtin_bit_cast(int, v), 0xB1, 0xF, 0xF, true));
    v += __builtin_bit_cast(float, __builtin_amdgcn_update_dpp(0, __builtin_bit_cast(int, v), 0x4E, 0xF, 0xF, true));
    v += __builtin_bit_cast(float, __builtin_amdgcn_update_dpp(0, __builtin_bit_cast(int, v), 0x141, 0xF, 0xF, true));
    return v;
}
__device__ __forceinline__ float bf2f(unsigned short b) { return __builtin_bit_cast(float, (unsigned)b << 16); }
__device__ __forceinline__ float bflo(unsigned w) { return __builtin_bit_cast(float, w << 16); }
__device__ __forceinline__ float bfhi(unsigned w) { return __builtin_bit_cast(float, w & 0xffff0000u); }
__device__ __forceinline__ float sigmoidf_(float x) { return __builtin_amdgcn_rcpf(1.0f + __builtin_amdgcn_exp2f(-x * LOG2E)); }
__device__ __forceinline__ float exp_(float x) { return __builtin_amdgcn_exp2f(x * LOG2E); }
__device__ __forceinline__ float wave_sum(float v) {
#pragma unroll
    for (int o = 1; o < 64; o <<= 1) v += __shfl_xor(v, o);
    return v;
}
__device__ __forceinline__ float wave_max(float v) {
#pragma unroll
    for (int o = 1; o < 64; o <<= 1) v = fmaxf(v, __shfl_xor(v, o));
    return v;
}

__device__ __forceinline__ int tid_fresh() { int t = threadIdx.x; asm volatile("" : "+v"(t)); return t; }

__device__ __forceinline__ int opaque_s(int x) { asm volatile("" : "+s"(x)); return x; }

struct Params {
    const float* in[29];
    float* out;
    unsigned char* ws;
};
namespace pg8 {
#define PG8_LAS __attribute__((address_space(3)))
typedef unsigned short bf16_t;
typedef short bf16x8 __attribute__((ext_vector_type(8)));
typedef float f32x4 __attribute__((ext_vector_type(4)));
typedef unsigned u32x4 __attribute__((ext_vector_type(4)));
constexpr int BM = 256, BK = 64, HALF = 128, HTB = HALF * BK * 2  , STAGE_BYTES = 8 * HTB, NXCD = 8, WGM = 8;

__host__ __device__ __forceinline__ int lds_byte(int r, int c) { const int st = (r >> 4) * 2 + (c >> 5), rr = r & 15, cc = c & 31, ob = rr * 64 + cc * 2; return st * 1024 + (ob ^ (((ob >> 9) & 1) << 5)); }
__host__ __device__ __forceinline__ void stage_rc(int b, int& R, int& C) { const int st = b / 1024, sb = b % 1024, swz = sb ^ (((sb >> 9) & 1) << 5); R = (st >> 1) * 16 + swz / 64; C = (st & 1) * 32 + (swz % 64) / 2; }
__host__ __device__ __forceinline__ int perm32(int rho) { const int n = rho >> 4, i = rho & 15; return 8 * (i >> 2) + 4 * n + (i & 3); }

struct Unit { int pm, pn; };
struct Gemm { const bf16_t* A; const bf16_t* Bt; int M, N, K, lda, ldb; };

struct StaticOrder {
    int nM, nN, nwg, G, c;
    __host__ __device__ void init(int M, int N, int G_, int c_) { nM = M / BM; nN = N / BM; nwg = nM * nN; G = G_; c = c_; }
    __host__ __device__ bool next(int i, Unit& u) const {
        const long L = (long)i * G + c; if (L >= nwg) return false;
        int wgid = (int)L; { const int q = nwg / NXCD, r = nwg % NXCD, xcd = wgid % NXCD, off = wgid / NXCD; wgid = (xcd < r ? xcd * (q + 1) : r * (q + 1) + (xcd - r) * q) + off; }
        const int nig = WGM * nN, gid = wgid / nig, fm = gid * WGM, gsz = (nM - fm) < WGM ? (nM - fm) : WGM;
        u.pm = fm + ((wgid % nig) % gsz); u.pn = (wgid % nig) / gsz; return true;
    }
    __device__ __forceinline__ void a_ready(const Unit&) const {}
    __device__ __forceinline__ void done(const Unit&) const {}
};


__device__ __forceinline__ unsigned cvt_pk_bf16(float lo, float hi) { unsigned r; asm volatile("v_cvt_pk_bf16_f32 %0, %1, %2" : "=v"(r) : "v"(lo), "v"(hi)); return r; }
typedef unsigned u32x2 __attribute__((ext_vector_type(2)));

struct EpiZ {
    static constexpr bool PERM = true, AFTER_DRAIN = false, MID = false;
    bf16_t* Z; bf16_t* VT; const float* rope; float* out;
    __device__ __forceinline__ void operator()(const f32x4 (&acc)[2][2][4][2], const Unit& u, int wr, int wc, int fr, int fq) const {
        const int pn = u.pn;
        const bool do_rope = (pn < 6) && ((wc & 1) == 0);
        const bool is_kv = (pn >= 3 && pn < 9);
        const int kvsel = is_kv ? (pn - 3) / 3 : 0;
        const int g = is_kv ? (pn - 3) % 3 : 0;
        const int W = 128 << (2 * g);
        const size_t okp = g == 0 ? O_KV128_P : (g == 1 ? O_KV512_P : O_KV2048_P);
        const size_t oks = g == 0 ? O_KV128_S : (g == 1 ? O_KV512_S : O_KV2048_S);
        const bool is_conv = (pn >= 9 && pn < 17);
        const float sgn = fq == 0 ? -1.f : 1.f;
#pragma unroll
        for (int ai = 0; ai < 2; ++ai)
#pragma unroll
            for (int m = 0; m < 4; ++m) {
                const int row = u.pm * BM + ai * HALF + wr * 64 + m * 16 + fr;
                const bool isP = row < MP, isS = (row >= MP) && (row < MT);
                const int b = isP ? (row >> 12) : (row - MP);
                const int t = row & 4095;
                float cosv[8], sinv[8];
                if (do_rope) {
                    const f32x4* cs = (const f32x4*)(rope + (size_t)(isP ? t : 4096) * 16);
#pragma unroll
                    for (int q = 0; q < 4; ++q) { const f32x4 c = cs[q]; cosv[2 * q] = c[0]; sinv[2 * q] = c[1]; cosv[2 * q + 1] = c[2]; sinv[2 * q + 1] = c[3]; }
                }
#pragma unroll
                for (int bj = 0; bj < 2; ++bj) {
                    f32x4 v0 = acc[ai][bj][m][0], v1 = acc[ai][bj][m][1];
                    const int cit = bj * HALF + wc * 32 + fq * 8;
                    if (do_rope) {
#pragma unroll
                        for (int j = 0; j < 4; ++j) {
                            const float p0 = __shfl_xor(v0[j], 16), p1 = __shfl_xor(v1[j], 16);
                            const float r0 = v0[j] * cosv[j] + sgn * p0 * sinv[j], r1 = v1[j] * cosv[4 + j] + sgn * p1 * sinv[4 + j];
                            v0[j] = fq < 2 ? r0 : v0[j]; v1[j] = fq < 2 ? r1 : v1[j];
                        }
                    }
                    if (pn < 3) { v0 = v0 * QSCALE; v1 = v1 * QSCALE; }
                    u32x4 w; w.x = cvt_pk_bf16(v0[0], v0[1]); w.y = cvt_pk_bf16(v0[2], v0[3]); w.z = cvt_pk_bf16(v1[0], v1[1]); w.w = cvt_pk_bf16(v1[2], v1[3]);
                    *(u32x4*)(Z + (size_t)row * NZ + pn * BM + cit) = w;
                    if (is_kv) {
                        float* dst = nullptr;
                        if (isP && t >= 4096 - W) dst = out + okp + ((size_t)(b * W + t - (4096 - W)) * 2 + kvsel) * 256 + cit;
                        else if (isS) dst = out + oks + ((size_t)(b * W + W - 1) * 2 + kvsel) * 256 + cit;
                        if (dst) { *(f32x4*)dst = v0; *(f32x4*)(dst + 4) = v1; }
                    }
                    if (is_conv) {
                        const int cc = pn * BM + cit - ZMQ;
                        float* dst = nullptr;
                        if (isP && t >= 4093) dst = out + O_CONV_P + (size_t)(b * 3 + t - 4093) * 2048 + cc;
                        else if (isS) dst = out + O_CONV_S + (size_t)(b * 3 + 2) * 2048 + cc;
                        if (dst) { *(f32x4*)dst = v0; *(f32x4*)(dst + 4) = v1; }
                    }
                }
            }
    }
};

struct EpiMix {
    static constexpr bool PERM = true, AFTER_DRAIN = false, MID = true;
    static constexpr int MID_T = 4;
    const bf16_t* Z; bf16_t* MIX;
    __device__ __forceinline__ void mid(f32x4 (&acc)[2][2][4][2], const Unit& u, int wr, int wc, int fr, int fq) const {
        int row0 = u.pm * BM + wr * 64 + fr, col0 = u.pn * BM + wc * 32 + fq * 8;
        asm volatile("" : "+v"(row0), "+v"(col0));
#pragma unroll
        for (int ai = 0; ai < 2; ++ai)
#pragma unroll
            for (int m = 0; m < 4; ++m) {
                const int row = row0 + ai * HALF + m * 16;
#pragma unroll
                for (int bj = 0; bj < 2; ++bj) {
                    const int col = col0 + bj * HALF;
                    const u32x4 za = *(const u32x4*)(Z + (size_t)row * NZ + ZGA + col), zb = *(const u32x4*)(Z + (size_t)row * NZ + ZGB + col);
#define MIXR(a_, b_) ((1.0f + __builtin_amdgcn_exp2f(-(b_) * LOG2E)) * __builtin_amdgcn_rcpf(1.0f + __builtin_amdgcn_exp2f(-(a_) * LOG2E)))
                    acc[ai][bj][m][0][0] *= MIXR(bflo(za.x), bflo(zb.x)); acc[ai][bj][m][0][1] *= MIXR(bfhi(za.x), bfhi(zb.x));
                    acc[ai][bj][m][0][2] *= MIXR(bflo(za.y), bflo(zb.y)); acc[ai][bj][m][0][3] *= MIXR(bfhi(za.y), bfhi(zb.y));
                    acc[ai][bj][m][1][0] *= MIXR(bflo(za.z), bflo(zb.z)); acc[ai][bj][m][1][1] *= MIXR(bfhi(za.z), bfhi(zb.z));
                    acc[ai][bj][m][1][2] *= MIXR(bflo(za.w), bflo(zb.w)); acc[ai][bj][m][1][3] *= MIXR(bfhi(za.w), bfhi(zb.w));
#undef MIXR
                    asm volatile("" ::: "memory"); __builtin_amdgcn_sched_barrier(0);
                }
            }
    }
    __device__ __forceinline__ void operator()(const f32x4 (&acc)[2][2][4][2], const Unit& u, int wr, int wc, int fr, int fq) const {
#pragma unroll
        for (int ai = 0; ai < 2; ++ai)
#pragma unroll
            for (int m = 0; m < 4; ++m) {
                const int row = u.pm * BM + ai * HALF + wr * 64 + m * 16 + fr;
#pragma unroll
                for (int bj = 0; bj < 2; ++bj) {
                    const int col = u.pn * BM + bj * HALF + wc * 32 + fq * 8;
                    const u32x4 zg = *(const u32x4*)(Z + (size_t)row * NZ + ZGB + col);
                    const f32x4 v0 = acc[ai][bj][m][0], v1 = acc[ai][bj][m][1];
                    u32x4 w;
                    w.x = cvt_pk_bf16(v0[0] * sigmoidf_(bflo(zg.x)), v0[1] * sigmoidf_(bfhi(zg.x)));
                    w.y = cvt_pk_bf16(v0[2] * sigmoidf_(bflo(zg.y)), v0[3] * sigmoidf_(bfhi(zg.y)));
                    w.z = cvt_pk_bf16(v1[0] * sigmoidf_(bflo(zg.z)), v1[1] * sigmoidf_(bfhi(zg.z)));
                    w.w = cvt_pk_bf16(v1[2] * sigmoidf_(bflo(zg.w)), v1[3] * sigmoidf_(bfhi(zg.w)));
                    *(u32x4*)(MIX + (size_t)row * DM + col) = w;
                    asm volatile("" ::: "memory");
                }
            }
    }
};
struct EpiRes {
    static constexpr bool PERM = false, AFTER_DRAIN = false, MID = false;
    const float* xp; bf16_t* HB; float* ss; int mode;
    __device__ __forceinline__ void operator()(const f32x4 (&acc)[2][2][4][2], const Unit& u, int wr, int wc, int fr, int fq) const {
#pragma unroll
        for (int ai = 0; ai < 2; ++ai)
#pragma unroll
            for (int m = 0; m < 4; ++m) {
                const int row = u.pm * BM + ai * HALF + wr * 64 + m * 16 + fr;
                float s = 0.f;
#pragma unroll
                for (int bj = 0; bj < 2; ++bj)
#pragma unroll
                    for (int n = 0; n < 2; ++n) {
                        const int col = u.pn * BM + bj * HALF + wc * 32 + n * 16 + fq * 4;
                        f32x4 h = acc[ai][bj][m][n];
                        if (mode) { const u32x2 hb = *(const u32x2*)(HB + (size_t)row * DM + col); h[0] += bflo(hb.x); h[1] += bfhi(hb.x); h[2] += bflo(hb.y); h[3] += bfhi(hb.y); }
                        else h = h + *(const f32x4*)(xp + (size_t)row * DM + col);
                        u32x2 w; w.x = cvt_pk_bf16(h[0], h[1]); w.y = cvt_pk_bf16(h[2], h[3]);
                        *(u32x2*)(HB + (size_t)row * DM + col) = w;
                        s += (h[0] * h[0] + h[1] * h[1]) + (h[2] * h[2] + h[3] * h[3]);
                    }
                s = sum_x32(sum_x16(s));
                if (fq == 0) ss[(size_t)row * 16 + u.pn * 4 + wc] = s;
                asm volatile("" ::: "memory");
            }
    }
};
__device__ __forceinline__ float row_rs(const float* ss, int row) {
    const f32x4* sp = (const f32x4*)(ss + (size_t)row * 16);
    const f32x4 a = sp[0], b = sp[1], c = sp[2], d = sp[3];
    const float tot = ((a[0] + a[1]) + (a[2] + a[3])) + ((b[0] + b[1]) + (b[2] + b[3])) + ((c[0] + c[1]) + (c[2] + c[3])) + ((d[0] + d[1]) + (d[2] + d[3]));
    return __builtin_amdgcn_rsqf(tot * (1.0f / 1024.0f) + EPSN);
}
struct EpiGU {
    static constexpr bool PERM = true, AFTER_DRAIN = false, MID = false;
    const float* ss; bf16_t* ACT;
    __device__ __forceinline__ void operator()(const f32x4 (&acc)[2][2][4][2], const Unit& u, int wr, int wc, int fr, int fq) const {
#pragma unroll
        for (int ai = 0; ai < 2; ++ai)
#pragma unroll
            for (int m = 0; m < 4; ++m) {
                const int row = u.pm * BM + ai * HALF + wr * 64 + m * 16 + fr;
                const float rs = row_rs(ss, row);
                float a[8];
#pragma unroll
                for (int n = 0; n < 2; ++n)
#pragma unroll
                    for (int j = 0; j < 4; ++j) { const float gt = rs * acc[ai][0][m][n][j], up = rs * acc[ai][1][m][n][j]; a[4 * n + j] = gt * sigmoidf_(gt) * up; }
                u32x4 w; w.x = cvt_pk_bf16(a[0], a[1]); w.y = cvt_pk_bf16(a[2], a[3]); w.z = cvt_pk_bf16(a[4], a[5]); w.w = cvt_pk_bf16(a[6], a[7]);
                *(u32x4*)(ACT + (size_t)row * DFF + u.pn * HALF + wc * 32 + fq * 8) = w;
            }
    }
};
struct EpiPle {
    static constexpr bool PERM = false, AFTER_DRAIN = false, MID = false;
    const float* ss2; bf16_t* PP; const bf16_t* HB; bf16_t* H3; float* ss3; int pass;
    __device__ __forceinline__ void operator()(const f32x4 (&acc)[2][2][4][2], const Unit& u, int wr, int wc, int fr, int fq) const {
#pragma unroll
        for (int ai = 0; ai < 2; ++ai)
#pragma unroll
            for (int m = 0; m < 4; ++m) {
                const int row = u.pm * BM + ai * HALF + wr * 64 + m * 16 + fr;
                if (pass == 0) {
#pragma unroll
                    for (int bj = 0; bj < 2; ++bj)
#pragma unroll
                        for (int n = 0; n < 2; ++n) { const f32x4 a = acc[ai][bj][m][n]; u32x2 w; w.x = cvt_pk_bf16(a[0], a[1]); w.y = cvt_pk_bf16(a[2], a[3]);
                            *(u32x2*)(PP + (size_t)row * DM + u.pn * BM + bj * HALF + wc * 32 + n * 16 + fq * 4) = w; }
                } else {
                    const float rs = row_rs(ss2, row);
                    float s = 0.f;
#pragma unroll
                    for (int bj = 0; bj < 2; ++bj)
#pragma unroll
                        for (int n = 0; n < 2; ++n) {
                            const size_t off = (size_t)row * DM + u.pn * BM + bj * HALF + wc * 32 + n * 16 + fq * 4;
                            const u32x2 pp = *(const u32x2*)(PP + off), hb = *(const u32x2*)(HB + off); const f32x4 a = acc[ai][bj][m][n];
                            f32x4 h;
                            h[0] = bflo(hb.x) + sigmoidf_(rs * a[0]) * bflo(pp.x); h[1] = bfhi(hb.x) + sigmoidf_(rs * a[1]) * bfhi(pp.x);
                            h[2] = bflo(hb.y) + sigmoidf_(rs * a[2]) * bflo(pp.y); h[3] = bfhi(hb.y) + sigmoidf_(rs * a[3]) * bfhi(pp.y);
                            u32x2 w; w.x = cvt_pk_bf16(h[0], h[1]); w.y = cvt_pk_bf16(h[2], h[3]);
                            *(u32x2*)(H3 + off) = w;
                            s += (h[0] * h[0] + h[1] * h[1]) + (h[2] * h[2] + h[3] * h[3]);
                        }
                    s = sum_x32(sum_x16(s));
                    if (fq == 0) ss3[(size_t)row * 16 + u.pn * 4 + wc] = s;
                }
                asm volatile("" ::: "memory");
            }
    }
};
template <class Epi, class Sched, bool ALIGN_EPI = false, bool SP2 = false>
__device__ __forceinline__ void gemm_phase(PG8_LAS unsigned char* lds, const Gemm g, const Sched& S, const Epi& E) {
    const int tid = tid_fresh(), wid = __builtin_amdgcn_readfirstlane(tid >> 6), lane = tid & 63, wr = wid >> 2, wc = wid & 3, fr = lane & 15, fq = lane >> 4;
    const int K = g.K, nt = K / BK;
    unsigned voffA[2], voffB[2];
#pragma unroll
    for (int i = 0; i < 2; ++i) { int R, C; stage_rc(tid * 16 + i * 8192, R, C); const int Rb = Epi::PERM ? ((R & ~31) + perm32(R & 31)) : R;
        voffA[i] = (unsigned)(R * g.lda + C) * 2u; voffB[i] = (unsigned)(Rb * g.ldb + C) * 2u; }
    const size_t kstep = (size_t)(BK * 2);
    const size_t hstepA = (size_t)HALF * g.lda * 2, hstepB = (size_t)HALF * g.ldb * 2;
    const size_t tstepA = 2 * hstepA, tstepB = 2 * hstepB;
    const unsigned ldsw = (unsigned)wid * 1024u;
    const int aoff = lds_byte(wr * 64 + fr, fq * 8), boff = lds_byte(wc * 32 + fr, fq * 8);
#define PG8_SA(b, h) (((b) * 2 + (h)) * HTB)
#define PG8_SB(b, h) ((4 + (b) * 2 + (h)) * HTB)
#define PG8_STAGE(bufoff, gbase, voff) do { _Pragma("unroll") for (int _i = 0; _i < 2; ++_i) \
        __builtin_amdgcn_global_load_lds((const unsigned*)((const char*)(gbase) + (voff)[_i]), (PG8_LAS unsigned*)(lds + (bufoff) + ldsw + _i * 8192), 16, 0, 0); } while (0)
#define PG8_LDA(dst, b, h) do { _Pragma("unroll") for (int m = 0; m < 4; ++m) _Pragma("unroll") for (int k = 0; k < 2; ++k) dst[m][k] = *(const PG8_LAS bf16x8*)(lds + PG8_SA(b, h) + aoff + m * 2048 + k * 1024); } while (0)
#define PG8_LDB(dst, b, h) do { _Pragma("unroll") for (int n = 0; n < 2; ++n) _Pragma("unroll") for (int k = 0; k < 2; ++k) dst[n][k] = *(const PG8_LAS bf16x8*)(lds + PG8_SB(b, h) + boff + n * 2048 + k * 1024); } while (0)
#define PG8_MMA(ai, bj, At, Bt) do { __builtin_amdgcn_s_setprio(1); _Pragma("unroll") for (int m = 0; m < 4; ++m) _Pragma("unroll") for (int n = 0; n < 2; ++n) _Pragma("unroll") for (int k = 0; k < 2; ++k) \
        acc[ai][bj][m][n] = __builtin_amdgcn_mfma_f32_16x16x32_bf16(Bt[n][k], At[m][k], acc[ai][bj][m][n], 0, 0, 0); __builtin_amdgcn_s_setprio(0); } while (0)
#define PG8_WAIT_V(n) asm volatile("s_waitcnt vmcnt(" #n ")" ::: "memory")
#define PG8_WAIT_L(n) asm volatile("s_waitcnt lgkmcnt(" #n ")" ::: "memory")
#define PG8_BAR __builtin_amdgcn_s_barrier()
#define PG8_SCHED __builtin_amdgcn_sched_barrier(0)
    Unit cur, nxt; int ui = 0;
    if (!S.next(0, cur)) return;
    f32x4 acc[2][2][4][2];
#pragma unroll
    for (int a = 0; a < 2; ++a)
#pragma unroll
        for (int b = 0; b < 2; ++b)
#pragma unroll
            for (int m = 0; m < 4; ++m)
#pragma unroll
                for (int n = 0; n < 2; ++n) acc[a][b][m][n] = (f32x4){0.f, 0.f, 0.f, 0.f};
    bf16x8 At[4][2], B0[2][2], B1[2][2];
    const char* cA = (const char*)g.A + (size_t)cur.pm * tstepA; const char* cB = (const char*)g.Bt + (size_t)cur.pn * tstepB;
    S.a_ready(cur);
    if constexpr (SP2) {
        PG8_STAGE(PG8_SB(0, 0), cB, voffB); PG8_STAGE(PG8_SB(0, 1), cB + hstepB, voffB); PG8_STAGE(PG8_SA(0, 0), cA, voffA); PG8_STAGE(PG8_SA(0, 1), cA + hstepA, voffA);
        if (wr == 1) PG8_BAR;
        PG8_WAIT_V(2); PG8_BAR;
        PG8_STAGE(PG8_SB(1, 0), cB + kstep, voffB); PG8_STAGE(PG8_SA(1, 0), cA + kstep, voffA); PG8_STAGE(PG8_SB(1, 1), cB + hstepB + kstep, voffB);
        PG8_WAIT_V(6); PG8_BAR;
    } else {
        PG8_STAGE(PG8_SB(0, 0), cB, voffB); PG8_STAGE(PG8_SA(0, 0), cA, voffA); PG8_STAGE(PG8_SB(0, 1), cB + hstepB, voffB); PG8_STAGE(PG8_SA(0, 1), cA + hstepA, voffA);
        if (wr == 1) PG8_BAR;
        PG8_WAIT_V(4); PG8_BAR;
        PG8_STAGE(PG8_SB(1, 0), cB + kstep, voffB); PG8_STAGE(PG8_SA(1, 0), cA + kstep, voffA); PG8_STAGE(PG8_SB(1, 1), cB + hstepB + kstep, voffB);
        PG8_WAIT_V(6); PG8_BAR;
    }
    for (;;) {
        const bool has_next = S.next(ui + 1, nxt);
        const char* nA = has_next ? (const char*)g.A + (size_t)nxt.pm * tstepA : cA; const char* nB = has_next ? (const char*)g.Bt + (size_t)nxt.pn * tstepB : cB;
        for (int t = 0; t < nt; t += 2) {
            if constexpr (Epi::MID) { if (t == Epi::MID_T) { __builtin_amdgcn_sched_barrier(0); E.mid(acc, cur, wr, wc, fr, fq); __builtin_amdgcn_sched_barrier(0); } }
            const bool last = (t == nt - 2);
            const char* a1 = cA + (size_t)(t + 1) * kstep;
            const char* a2 = last ? nA : cA + (size_t)(t + 2) * kstep; const char* b2 = last ? nB : cB + (size_t)(t + 2) * kstep;
            const char* a3 = a2 + kstep; const char* b3 = b2 + kstep;
            if (last && has_next) S.a_ready(nxt);
            if constexpr (SP2) {
            PG8_LDB(B0, 0, 0); PG8_LDB(B1, 0, 1); PG8_SCHED; PG8_LDA(At, 0, 0); PG8_STAGE(PG8_SA(1, 1), a1 + hstepA, voffA);
            PG8_WAIT_V(8); PG8_WAIT_L(0); PG8_BAR; PG8_MMA(0, 0, At, B0); PG8_MMA(0, 1, At, B1); PG8_BAR; PG8_SCHED;
            PG8_LDA(At, 0, 1); PG8_STAGE(PG8_SB(0, 0), b2, voffB); PG8_STAGE(PG8_SB(0, 1), b2 + hstepB, voffB); PG8_STAGE(PG8_SA(0, 0), a2, voffA);
            PG8_WAIT_V(8); PG8_WAIT_L(0); PG8_BAR; PG8_MMA(1, 0, At, B0); PG8_MMA(1, 1, At, B1); PG8_BAR; PG8_SCHED;
            PG8_LDB(B0, 1, 0); PG8_LDB(B1, 1, 1); PG8_SCHED; PG8_LDA(At, 1, 0); PG8_STAGE(PG8_SA(0, 1), a2 + hstepA, voffA);
            PG8_WAIT_V(8); PG8_WAIT_L(0); PG8_BAR; PG8_MMA(0, 0, At, B0); PG8_MMA(0, 1, At, B1); PG8_BAR; PG8_SCHED;
            PG8_LDA(At, 1, 1); PG8_STAGE(PG8_SB(1, 0), b3, voffB); PG8_STAGE(PG8_SB(1, 1), b3 + hstepB, voffB); PG8_STAGE(PG8_SA(1, 0), a3, voffA);
            PG8_WAIT_V(8); PG8_WAIT_L(0); PG8_BAR; PG8_MMA(1, 0, At, B0); PG8_MMA(1, 1, At, B1); PG8_BAR; PG8_SCHED;
            } else {
            PG8_LDB(B0, 0, 0); PG8_SCHED; PG8_LDA(At, 0, 0); PG8_STAGE(PG8_SA(1, 1), a1 + hstepA, voffA);
            PG8_WAIT_L(8); PG8_BAR; PG8_WAIT_L(0); PG8_MMA(0, 0, At, B0); PG8_BAR; PG8_SCHED;
            PG8_LDB(B1, 0, 1); PG8_STAGE(PG8_SB(0, 0), b2, voffB);
            PG8_BAR; PG8_WAIT_L(0); PG8_MMA(0, 1, At, B1); PG8_BAR;
            PG8_LDA(At, 0, 1); PG8_STAGE(PG8_SA(0, 0), a2, voffA);
            PG8_BAR; PG8_WAIT_L(0); PG8_MMA(1, 0, At, B0); PG8_BAR; PG8_SCHED;
            PG8_STAGE(PG8_SB(0, 1), b2 + hstepB, voffB);
            PG8_WAIT_V(6); PG8_BAR; PG8_MMA(1, 1, At, B1); PG8_BAR;
            PG8_LDB(B0, 1, 0); PG8_SCHED; PG8_LDA(At, 1, 0); PG8_STAGE(PG8_SA(0, 1), a2 + hstepA, voffA);
            PG8_WAIT_L(8); PG8_BAR; PG8_WAIT_L(0); PG8_MMA(0, 0, At, B0); PG8_BAR; PG8_SCHED;
            PG8_LDB(B1, 1, 1); PG8_STAGE(PG8_SB(1, 0), b3, voffB);
            PG8_BAR; PG8_WAIT_L(0); PG8_MMA(0, 1, At, B1); PG8_BAR;
            PG8_LDA(At, 1, 1); PG8_STAGE(PG8_SA(1, 0), a3, voffA);
            PG8_BAR; PG8_WAIT_L(0); PG8_MMA(1, 0, At, B0); PG8_BAR; PG8_SCHED;
            PG8_STAGE(PG8_SB(1, 1), b3 + hstepB, voffB);
            PG8_WAIT_V(6); PG8_BAR; PG8_MMA(1, 1, At, B1); PG8_BAR;
            }
        }
        if constexpr (ALIGN_EPI) { if (wr == 0) PG8_BAR; }
        if constexpr (!Epi::AFTER_DRAIN) { E(acc, cur, wr, wc, fr, fq); S.done(cur); }
        if (!has_next) break;
#pragma unroll
        for (int a = 0; a < 2; ++a)
#pragma unroll
            for (int b = 0; b < 2; ++b)
#pragma unroll
                for (int m = 0; m < 4; ++m)
#pragma unroll
                    for (int n = 0; n < 2; ++n) acc[a][b][m][n] = (f32x4){0.f, 0.f, 0.f, 0.f};
        cur = nxt; cA = nA; cB = nB; ++ui;
        if constexpr (ALIGN_EPI) { if (wr == 1) PG8_BAR; }
    }
    PG8_WAIT_V(0);
    if constexpr (!ALIGN_EPI) { if (wr == 0) PG8_BAR; }
    PG8_BAR;
    if constexpr (Epi::AFTER_DRAIN) { E.fused(acc, cur, wr, wc, fr, fq, lds, wid, lane); S.done(cur); }
#undef PG8_SA
#undef PG8_SB
#undef PG8_STAGE
#undef PG8_LDA
#undef PG8_LDB
#undef PG8_MMA
#undef PG8_WAIT_V
#undef PG8_WAIT_L
#undef PG8_BAR
#undef PG8_SCHED
}
}

__device__ __forceinline__ void transpose_item(const float* __restrict__ W, int ldw, int k0, int n0src, bf16* __restrict__ WT, int ldt, int drow0, const float* __restrict__ gain, LAS float* scr, int lane, int kdst = 0) {
#pragma unroll 8
    for (int i = 0; i < 32; ++i) { const int kk = 2 * i + (lane >> 5); float v = W[(size_t)(k0 + kk) * ldw + n0src + (lane & 31)]; if (gain) v *= gain[k0 + kk]; scr[kk * 33 + (lane & 31)] = v; }
    asm volatile("s_waitcnt lgkmcnt(0)" ::: "memory");
    const int c = lane & 7;
#pragma unroll
    for (int j = 0; j < 4; ++j) { const int n = (lane >> 3) + 8 * j; const LAS float* s = scr + (8 * c) * 33 + n;
        u32x4v o; o.x = pk2(s[0 * 33], s[1 * 33]); o.y = pk2(s[2 * 33], s[3 * 33]); o.z = pk2(s[4 * 33], s[5 * 33]); o.w = pk2(s[6 * 33], s[7 * 33]);
        *(u32x4v*)(WT + (size_t)(drow0 + n) * ldt + kdst + k0 + 8 * c) = o; }
    asm volatile("s_waitcnt lgkmcnt(0)" ::: "memory");
}

__device__ __forceinline__ void convert_weights(const Params& P, LAS unsigned char* lds, int gw, int NGW, int it0, int it1) {
    const int tid = tid_fresh(), lane = tid & 63, wave = tid >> 6;
    unsigned char* ws = P.ws;
    LAS float* scr = (LAS float*)(lds + wave * 8448);
    constexpr int I_IN = 16 * 264, I_A = 4 * 32, I_B = 16 * 32, I_O = 16 * 32, I_G = 16 * 88, I_U = 16 * 88, I_D = 44 * 32, I_PG = 16 * 32, I_PP = 4 * 32;
    for (int it = it0 + gw; it < it1; it += NGW) {
        int r = it;
        if (r < I_IN) { const int kb = r / 264, nb = r % 264, n0 = nb * 32; transpose_item(P.in[12], 8456, kb * 64, n0 + (n0 >= 6400 ? 8 : 0), (bf16*)(ws + WS_WIN), DM, n0, P.in[11], scr, lane); continue; } r -= I_IN;
        if (r < I_A) { const int kb = r / 32, nb = r % 32; transpose_item(P.in[18], DM, kb * 64, nb * 32, (bf16*)(ws + WS_WA), KMIX, nb * 32, nullptr, scr, lane, 0); continue; } r -= I_A;
        if (r < I_B) { const int kb = r / 32, nb = r % 32; transpose_item(P.in[19], DM, kb * 64, nb * 32, (bf16*)(ws + WS_WA), KMIX, nb * 32, nullptr, scr, lane, 256); continue; } r -= I_B;
        if (r < I_O) { const int kb = r / 32, nb = r % 32; transpose_item(P.in[20], DM, kb * 64, nb * 32, (bf16*)(ws + WS_WO), DM, nb * 32, nullptr, scr, lane); continue; } r -= I_O;
        if (r < I_G) { const int kb = r / 88, nb = r % 88, n0 = nb * 32; transpose_item(P.in[22], DFF, kb * 64, n0, (bf16*)(ws + WS_WGU), DM, 256 * (n0 >> 7) + (n0 & 127), P.in[21], scr, lane); continue; } r -= I_G;
        if (r < I_U) { const int kb = r / 88, nb = r % 88, n0 = nb * 32; transpose_item(P.in[23], DFF, kb * 64, n0, (bf16*)(ws + WS_WGU), DM, 256 * (n0 >> 7) + 128 + (n0 & 127), P.in[21], scr, lane); continue; } r -= I_U;
        if (r < I_D) { const int kb = r / 32, nb = r % 32; transpose_item(P.in[24], DM, kb * 64, nb * 32, (bf16*)(ws + WS_WD), DFF, nb * 32, nullptr, scr, lane); continue; } r -= I_D;
        if (r < I_PG) { const int kb = r / 32, nb = r % 32; transpose_item(P.in[26], DM, kb * 64, nb * 32, (bf16*)(ws + WS_WPG), DM, nb * 32, P.in[25], scr, lane); continue; } r -= I_PG;
        { const int kb = r / 32, nb = r % 32; transpose_item(P.in[27], DM, kb * 64, nb * 32, (bf16*)(ws + WS_WPP), 256, nb * 32, nullptr, scr, lane); }
    }
}
constexpr int W_ITEMS_ALL = 16 * 264 + 4 * 32 + 16 * 32 + 16 * 32 + 16 * 88 + 16 * 88 + 44 * 32 + 16 * 32 + 4 * 32;

__device__ __forceinline__ void phase0(const Params& P, LAS unsigned char* lds, int G) {
    const int tid = tid_fresh(), lane = tid & 63, wave = tid >> 6;
    const int gw = blockIdx.x * 8 + wave, NGW = G * 8;
    unsigned char* ws = P.ws;
    const float* w_in = P.in[12];
    const float* norm_mix = P.in[11];
    LAS float* wg = (LAS float*)(lds + 72 * 1024);
    for (int idx = tid; idx < 8192; idx += 512) { const int j = idx >> 10, k = idx & 1023; wg[idx] = w_in[(size_t)k * 8456 + 6400 + j] * norm_mix[k]; }
    __syncthreads();
    {
        const float* xp = P.in[0]; const float* xs = P.in[1];
        bf16* XN = (bf16*)(ws + WS_XN); float* GT = (float*)(ws + WS_GATES);
        const float* b_ig = P.in[15]; const float* b_fg = P.in[16];
        for (int row = gw; row < MT; row += NGW) {
            const float* xr = row < MP ? xp + (size_t)row * DM : xs + (size_t)(row - MP) * DM;
            f32x4v v[4]; float s = 0.f;
#pragma unroll
            for (int j = 0; j < 4; ++j) { v[j] = *(const f32x4v*)(xr + 256 * j + 4 * lane); s += (v[j][0] * v[j][0] + v[j][1] * v[j][1]) + (v[j][2] * v[j][2] + v[j][3] * v[j][3]); }
            const float rs = 1.0f / sqrtf(wave_sum(s) * (1.0f / DM) + EPSN);
#pragma unroll
            for (int j = 0; j < 4; ++j) { v[j] = v[j] * rs; u32x2v w; w.x = pk2(v[j][0], v[j][1]); w.y = pk2(v[j][2], v[j][3]); *(u32x2v*)(XN + (size_t)row * DM + 256 * j + 4 * lane) = w; }
            float d[8];
#pragma unroll
            for (int gi = 0; gi < 8; ++gi) {
                float s_ = 0.f;
#pragma unroll
                for (int j = 0; j < 4; ++j) { const f32x4v w = *(const LAS f32x4v*)(wg + gi * 1024 + 256 * j + 4 * lane); s_ += (v[j][0] * w[0] + v[j][1] * w[1]) + (v[j][2] * w[2] + v[j][3] * w[3]); }
                d[gi] = s_;
            }
            { const bool b0 = lane & 1, b1 = lane & 2, b2 = lane & 4;
#pragma unroll
              for (int i = 0; i < 4; ++i) { const float snd = b0 ? d[i] : d[i + 4], kp = b0 ? d[i + 4] : d[i]; d[i] = kp + __shfl_xor(snd, 1); }
#pragma unroll
              for (int i = 0; i < 2; ++i) { const float snd = b1 ? d[i] : d[i + 2], kp = b1 ? d[i + 2] : d[i]; d[i] = kp + __shfl_xor(snd, 2); }
              { const float snd = b2 ? d[0] : d[1], kp = b2 ? d[1] : d[0]; d[0] = kp + __shfl_xor(snd, 4); }
              d[0] += __shfl_xor(d[0], 8); d[0] += __shfl_xor(d[0], 16); d[0] += __shfl_xor(d[0], 32); }
            if (lane < 8) {
                const int gidx = 4 * (lane & 1) + 2 * ((lane >> 1) & 1) + ((lane >> 2) & 1);
                const float mine = d[0];
                if (gidx < 4) GT[(size_t)row * 8 + gidx] = mine + b_ig[gidx];
                else { const float x = mine + b_fg[gidx - 4]; const float e = exp_(-fabsf(x));
                    const float l1p = e < 0.02f ? e * (1.0f - e * (0.5f - e * (0.33333333f - 0.25f * e))) : __logf(1.0f + e);
                    GT[(size_t)row * 8 + gidx] = fminf(x, 0.f) - l1p; }
            }
        }
    }
    if (blockIdx.x == 0) { for (int i = tid; i < MS * 16; i += 512) { ((float*)(ws + WS_SS1))[(size_t)MP * 16 + i] = 0.f; ((float*)(ws + WS_SS2))[(size_t)MP * 16 + i] = 0.f; ((float*)(ws + WS_SS3))[(size_t)MP * 16 + i] = 0.f; } }
    {
        const float* pp = P.in[9]; const float* ps = P.in[10]; bf16* PB = (bf16*)(ws + WS_PB);
        for (int idx = blockIdx.x * 512 + tid; idx < MT * 32; idx += G * 512) {
            const int row = idx >> 5, c = (idx & 31) * 8;
            const float* src = row < MP ? pp + (size_t)row * 256 + c : ps + (size_t)(row - MP) * 256 + c;
            const f32x4v a = *(const f32x4v*)src, b = *(const f32x4v*)(src + 4);
            u32x4v o; o.x = pk2(a[0], a[1]); o.y = pk2(a[2], a[3]); o.z = pk2(b[0], b[1]); o.w = pk2(b[2], b[3]);
            *(u32x4v*)(PB + (size_t)row * 256 + c) = o;
        }
    }
    {
        float* RT = (float*)(ws + WS_ROPE);
        for (int idx = blockIdx.x * 512 + tid; idx < 4097 * 8; idx += G * 512) {
            const int pi = idx >> 3, i = idx & 7;
            const float inv = i == 0 ? 1.0f : i == 1 ? 0.193922743f : i == 2 ? 0.0376060307f : i == 3 ? 0.00729266461f : i == 4 ? 0.00141421356f : i == 5 ? 0.000274248188f : i == 6 ? 5.31829573e-05f : 1.03133852e-05f;
            const float ang = (float)(pi < 4096 ? pi : 16384) * inv;
            double rev = (double)ang * 0.15915494309189535; rev -= floor(rev);
            const float rf = (float)rev;
            RT[2 * idx] = __builtin_amdgcn_cosf(rf); RT[2 * idx + 1] = __builtin_amdgcn_sinf(rf);
        }
    }
    convert_weights(P, lds, gw, NGW, 0, 16 * 264);
}

typedef float f32x16v __attribute__((ext_vector_type(16)));
__device__ __forceinline__ int crow(int i, int h) { return (i & 3) + 8 * (i >> 2) + 4 * h; }

__device__ __forceinline__ void attn_task(const bf16* __restrict__ Z, const bf16* __restrict__ VT, bf16* __restrict__ OG, float* __restrict__ LSE, int task, int lane, LAS unsigned char* vl) {
    const int tile = task & 127, bh = task >> 7, hinst = bh % 12, b = bh / 12;
    const int g = hinst >> 2, h = hinst & 3, lg = 2 * g, nsub = 4096 >> lg;
    const int res = tile >> (7 - lg), qt = tile & ((128 >> lg) - 1), q0 = qt * 32;
    const int r32 = lane & 31, hi = lane >> 5;
    const int tq = ((q0 + r32) << lg) + res;
    const size_t rowq = (size_t)b * 4096 + tq;
    const bf16* qp = Z + rowq * NZ + ZQ + hinst * 64 + 8 * hi;
    s16x8v qf[4];
#pragma unroll
    for (int s = 0; s < 4; ++s) qf[s] = *(const s16x8v*)(qp + 16 * s);
    s16x8v kf[5][4];
#pragma unroll
    for (int kt = 0; kt < 5; ++kt) {
        const int kb = q0 - 128 + 32 * kt;
        const int tk = (((kb >= 0 ? kb : 0) + r32) << lg) + res;
        const bf16* kp = Z + ((size_t)b * 4096 + tk) * NZ + ZK + hinst * 64 + 8 * hi;
#pragma unroll
        for (int s = 0; s < 4; ++s) kf[kt][s] = *(const s16x8v*)(kp + 16 * s);
    }
    f32x16v sc[5];
    const float NEGINF = -__builtin_inff();
#pragma unroll
    for (int kt = 0; kt < 5; ++kt) {
        const int kb = q0 - 128 + 32 * kt;
        f32x16v a;
#pragma unroll
        for (int i = 0; i < 16; ++i) a[i] = 0.f;
#pragma unroll
        for (int s = 0; s < 4; ++s) a = __builtin_amdgcn_mfma_f32_32x32x16_bf16(kf[kt][s], qf[s], a, 0, 0, 0);
        if (kt == 0) {
#pragma unroll
            for (int i = 0; i < 16; ++i) if (crow(i, hi) < r32) a[i] = NEGINF;
        }
        if (kt == 4) {
#pragma unroll
            for (int i = 0; i < 16; ++i) if (crow(i, hi) > r32) a[i] = NEGINF;
        }
        if (kb < 0) {
#pragma unroll
            for (int i = 0; i < 16; ++i) a[i] = NEGINF;
        }
        sc[kt] = a;
    }
    const int vkey = lane >> 3, vpc = lane & 7;
    u32x4v vr[5][4];
#pragma unroll
    for (int kt = 0; kt < 5; ++kt) {
        const int kb = q0 - 128 + 32 * kt, kbc = kb >= 0 ? kb : 0;
#pragma unroll
        for (int i = 0; i < 4; ++i) { const int tv = ((kbc + vkey + 8 * i) << lg) + res; vr[kt][i] = *(const u32x4v*)(Z + ((size_t)b * 4096 + tv) * NZ + ZV + hinst * 64 + vpc * 8); }
    }
    float m = NEGINF;
#pragma unroll
    for (int kt = 0; kt < 5; ++kt)
#pragma unroll
        for (int i = 0; i < 16; ++i) m = fmaxf(m, sc[kt][i]);
    m = max_x32(m);
    float l = 0.f;
#pragma unroll
    for (int kt = 0; kt < 5; ++kt)
#pragma unroll
        for (int i = 0; i < 16; ++i) { const float p = __builtin_amdgcn_exp2f(sc[kt][i] - m); sc[kt][i] = p; l += p; }
    l = sum_x32(l);
    f32x16v o0, o1;
#pragma unroll
    for (int i = 0; i < 16; ++i) { o0[i] = 0.f; o1[i] = 0.f; }
    {
        const int q4 = (lane & 15) >> 2, p4 = lane & 3, dh = (lane >> 4) & 1;
        const int troff = (4 * hi + q4) * 144 + dh * 32 + 8 * p4;
#pragma unroll
        for (int kt = 0; kt < 5; ++kt) {
#pragma unroll
            for (int i = 0; i < 4; ++i) *(LAS u32x4v*)(vl + (vkey + 8 * i) * 144 + vpc * 16) = vr[kt][i];
            asm volatile("s_waitcnt lgkmcnt(0)" ::: "memory");
            typedef short v4s_t __attribute__((ext_vector_type(4)));
            v4s_t tl[2][2], th[2][2];
#pragma unroll
            for (int s2 = 0; s2 < 2; ++s2)
#pragma unroll
                for (int dt = 0; dt < 2; ++dt) {
                    tl[s2][dt] = __builtin_amdgcn_ds_read_tr16_b64_v4i16((LAS v4s_t*)(vl + troff + (16 * s2) * 144 + dt * 64));
                    th[s2][dt] = __builtin_amdgcn_ds_read_tr16_b64_v4i16((LAS v4s_t*)(vl + troff + (16 * s2 + 8) * 144 + dt * 64));
                }
#pragma unroll
            for (int s2 = 0; s2 < 2; ++s2) {
                u32x4v pw;
                pw.x = pk2(sc[kt][8 * s2 + 0], sc[kt][8 * s2 + 1]); pw.y = pk2(sc[kt][8 * s2 + 2], sc[kt][8 * s2 + 3]);
                pw.z = pk2(sc[kt][8 * s2 + 4], sc[kt][8 * s2 + 5]); pw.w = pk2(sc[kt][8 * s2 + 6], sc[kt][8 * s2 + 7]);
                const s16x8v pf = __builtin_bit_cast(s16x8v, pw);
                const s16x8v fa = __builtin_shufflevector(tl[s2][0], th[s2][0], 0, 1, 2, 3, 4, 5, 6, 7), fb = __builtin_shufflevector(tl[s2][1], th[s2][1], 0, 1, 2, 3, 4, 5, 6, 7);
                o0 = __builtin_amdgcn_mfma_f32_32x32x16_bf16(fa, pf, o0, 0, 0, 0);
                o1 = __builtin_amdgcn_mfma_f32_32x32x16_bf16(fb, pf, o1, 0, 0, 0);
            }
            asm volatile("s_waitcnt lgkmcnt(0)" ::: "memory");
        }
    }
    const float inv = 1.0f / l;
    bf16* op = OG + ((size_t)g * MPAD + rowq) * 256 + h * 64 + 4 * hi;
#pragma unroll
    for (int gq = 0; gq < 4; ++gq) {
        u32x2v w0, w1;
        w0.x = pk2(o0[4 * gq] * inv, o0[4 * gq + 1] * inv); w0.y = pk2(o0[4 * gq + 2] * inv, o0[4 * gq + 3] * inv);
        w1.x = pk2(o1[4 * gq] * inv, o1[4 * gq + 1] * inv); w1.y = pk2(o1[4 * gq + 2] * inv, o1[4 * gq + 3] * inv);
        *(u32x2v*)(op + 8 * gq) = w0; *(u32x2v*)(op + 32 + 8 * gq) = w1;
    }
    if (hi == 0) LSE[((size_t)g * MPAD + rowq) * 4 + h] = (m + __log2f(l)) * LN2;
}

__device__ __forceinline__ void sample_attn_task(const Params& P, const bf16* __restrict__ Z, bf16* __restrict__ OG, float* __restrict__ LSE, int task, int lane, LAS float* pS) {
    const int hinst = task % 12, b = task / 12, g = hinst >> 2, h = hinst & 3, lg = 2 * g, W = 128 << lg;
    const float* cache = P.in[2 + g];
    const size_t row = (size_t)MP + b;
    float q[64];
    {
        const bf16* qp = Z + row * NZ + ZQ + hinst * 64;
#pragma unroll
        for (int c = 0; c < 8; ++c) { const u32x4v w = *(const u32x4v*)(qp + 8 * c);
            q[8 * c] = bflo(w.x); q[8 * c + 1] = bfhi(w.x); q[8 * c + 2] = bflo(w.y); q[8 * c + 3] = bfhi(w.y); q[8 * c + 4] = bflo(w.z); q[8 * c + 5] = bfhi(w.z); q[8 * c + 6] = bflo(w.w); q[8 * c + 7] = bfhi(w.w); }
    }
    float s[3];
#pragma unroll
    for (int rr = 0; rr < 3; ++rr) {
        const int i = lane + 64 * rr;
        float d = -__builtin_inff();
        if (i <= 128 && (rr < 2 || lane == 0)) {
            d = 0.f;
            if (i == 0) {
                const bf16* kp = Z + row * NZ + ZK + hinst * 64;
#pragma unroll
                for (int c = 0; c < 8; ++c) { const u32x4v w = *(const u32x4v*)(kp + 8 * c);
                    d += q[8 * c] * bflo(w.x) + q[8 * c + 1] * bfhi(w.x) + q[8 * c + 2] * bflo(w.y) + q[8 * c + 3] * bfhi(w.y) + q[8 * c + 4] * bflo(w.z) + q[8 * c + 5] * bfhi(w.z) + q[8 * c + 6] * bflo(w.w) + q[8 * c + 7] * bfhi(w.w); }
            } else {
                const float* kp = cache + (((size_t)b * W + (W - (i << lg))) * 2 + 0) * 256 + h * 64;
#pragma unroll
                for (int c = 0; c < 16; ++c) { const f32x4v w = *(const f32x4v*)(kp + 4 * c); d += q[4 * c] * w[0] + q[4 * c + 1] * w[1] + q[4 * c + 2] * w[2] + q[4 * c + 3] * w[3]; }
            }
        }
        s[rr] = d;
    }
    const float m = wave_max(fmaxf(fmaxf(s[0], s[1]), s[2]));
    float l = 0.f;
#pragma unroll
    for (int rr = 0; rr < 3; ++rr) { const float p = __builtin_amdgcn_exp2f(s[rr] - m); l += p; const int i = lane + 64 * rr; if (i <= 128 && (rr < 2 || lane == 0)) pS[i] = p; }
    l = wave_sum(l);
    asm volatile("s_waitcnt lgkmcnt(0)" ::: "memory");
    float o = pS[0] * bf2f(Z[row * NZ + ZV + hinst * 64 + lane]);
    for (int i0 = 1; i0 <= 128; i0 += 16) {
        float vv[16];
#pragma unroll
        for (int u = 0; u < 16; ++u) vv[u] = cache[(((size_t)b * W + (W - ((i0 + u) << lg))) * 2 + 1) * 256 + h * 64 + lane];
#pragma unroll
        for (int u = 0; u < 16; ++u) o += pS[i0 + u] * vv[u];
    }
    OG[((size_t)g * MPAD + row) * 256 + h * 64 + lane] = (bf16)f2bf(o / l);
    if (lane == 0) LSE[((size_t)g * MPAD + row) * 4 + h] = (m + __log2f(l)) * LN2;
    asm volatile("s_waitcnt lgkmcnt(0)" ::: "memory");
}

__device__ __forceinline__ void attention_work(const Params& P, LAS unsigned char* lds, int wv, int nwv) {
    const int tid = tid_fresh(), lane = tid & 63, wave = tid >> 6;
    unsigned char* ws = P.ws;
    const bf16* Z = (const bf16*)(ws + WS_Z); const bf16* VT = (const bf16*)(ws + WS_VT);
    bf16* OG = (bf16*)(ws + WS_OG); float* LSE = (float*)(ws + WS_LSE);
    for (int rp_ = 0, nrp_ = opaque_s(REP_SA); rp_ < nrp_; ++rp_)
    for (int task = wv; task < 32 * 12; task += nwv) sample_attn_task(P, Z, OG, LSE, task, lane, (LAS float*)(lds + wave * 1024));
    for (int rp_ = 0, nrp_ = opaque_s(REP_AT); rp_ < nrp_; ++rp_)
    for (int task = wv; task < 4 * 12 * 128; task += nwv) attn_task(Z, VT, OG, LSE, task, lane, lds + 16384 + wave * 4608);
}

__device__ __forceinline__ void gate_scan_task(const float* __restrict__ GT, f32x4v* __restrict__ GS, int task, int lane);
__device__ __forceinline__ void phase2a(const Params& P, LAS unsigned char* lds, int G) {
    const int tid = tid_fresh(), lane = tid & 63, wave = tid >> 6;
    const int gw = blockIdx.x * 8 + wave, NGW = G * 8;
    unsigned char* ws = P.ws;
    const bf16* Z = (const bf16*)(ws + WS_Z);
    for (int task = gw; task < 1024; task += NGW) gate_scan_task((const float*)(ws + WS_GATES), (f32x4v*)(ws + WS_GS), task, lane);
    {
        bf16* QK = (bf16*)(ws + WS_QK); const float* cw = P.in[13]; const float* cb = P.in[14];
        for (int rp_ = 0, nrp_ = opaque_s(REP_CV); rp_ < nrp_; ++rp_)
        for (int idx = blockIdx.x * 512 + tid; idx < (MP / 4) * 256; idx += G * 512) {
            const int row0 = (idx >> 8) * 4, c = (idx & 255) * 8, t0 = row0 & 4095;
            u32x4v zr[7];
#pragma unroll
            for (int j = 0; j < 7; ++j) { if (t0 + j - 3 >= 0) zr[j] = *(const u32x4v*)(Z + (size_t)(row0 + j - 3) * NZ + ZMQ + c); else zr[j] = (u32x4v){0u, 0u, 0u, 0u}; }
            f32x4v w[4][2];
#pragma unroll
            for (int j = 0; j < 4; ++j) { w[j][0] = *(const f32x4v*)(cw + j * 2048 + c); w[j][1] = *(const f32x4v*)(cw + j * 2048 + c + 4); }
            const f32x4v b0 = *(const f32x4v*)(cb + c), b1 = *(const f32x4v*)(cb + c + 4);
            const float sc = c >= 1024 ? 0.0625f : 1.0f;
#pragma unroll
            for (int r = 0; r < 4; ++r) {
                float y[8] = {b0[0], b0[1], b0[2], b0[3], b1[0], b1[1], b1[2], b1[3]};
#pragma unroll
                for (int j = 0; j < 4; ++j) { const u32x4v z = zr[r + j];
                    y[0] += w[j][0][0] * bflo(z.x); y[1] += w[j][0][1] * bfhi(z.x); y[2] += w[j][0][2] * bflo(z.y); y[3] += w[j][0][3] * bfhi(z.y);
                    y[4] += w[j][1][0] * bflo(z.z); y[5] += w[j][1][1] * bfhi(z.z); y[6] += w[j][1][2] * bflo(z.w); y[7] += w[j][1][3] * bfhi(z.w); }
#pragma unroll
                for (int j = 0; j < 8; ++j) y[j] = y[j] * sigmoidf_(y[j]) * sc;
                u32x4v o; o.x = pk2(y[0], y[1]); o.y = pk2(y[2], y[3]); o.z = pk2(y[4], y[5]); o.w = pk2(y[6], y[7]);
                *(u32x4v*)(QK + (size_t)(row0 + r) * 2048 + c) = o;
            }
        }
    }
    {
        const float* sc = P.in[5]; float* out = P.out + O_CONV_S;
        for (int idx = blockIdx.x * 512 + tid; idx < 32 * 2 * 2048; idx += G * 512) { const int b = idx / 4096, r = (idx >> 11) & 1, c = idx & 2047; out[(size_t)(b * 3 + r) * 2048 + c] = sc[(size_t)(b * 3 + r + 1) * 2048 + c]; }
    }
}
#define XB_TMO      128
#define XB_XCNT(j)  (256  + 64 * (j))
#define XB_XSUB(j)  (1280 + 64 * (j))
#define XB_XGEN(j)  (2304 + 64 * (j))
#define XB_TOP      3328
#define XB_TOPGEN   3392
#define XCD_BAR_WORDS 3456
#define XB_SPIN_CAP (1u << 18)

__device__ __forceinline__ unsigned xb_ld(unsigned* p)              { return __hip_atomic_load(p, __ATOMIC_RELAXED, __HIP_MEMORY_SCOPE_AGENT); }
__device__ __forceinline__ unsigned xb_add(unsigned* p, unsigned v) { return __hip_atomic_fetch_add(p, v, __ATOMIC_RELAXED, __HIP_MEMORY_SCOPE_AGENT); }
__device__ __forceinline__ unsigned xb_xcc_id() { return (unsigned)__builtin_amdgcn_s_getreg((3 << 11) | 20) & 0xFu; }
#define XB_SPIN(cond, bar) do { unsigned _sp = 0; while (cond) { __builtin_amdgcn_s_sleep(1); \
    if ((++_sp & 255u) == 0u) { if (xb_ld(&(bar)[XB_TMO])) break; if (_sp > XB_SPIN_CAP) { atomicAdd(&(bar)[XB_TMO], 1u); break; } } } } while (0)

struct XcdBarrier {
    unsigned* bar; unsigned x;
    volatile LAS unsigned* st;
};

__device__ __forceinline__ XcdBarrier xcd_barrier_post(unsigned* bar, volatile LAS unsigned* st) {
    XcdBarrier b; b.bar = bar; b.x = xb_xcc_id(); b.st = st;
    if (threadIdx.x == 0) (void)xb_add(&bar[XB_XCNT(b.x)], 1u);
    return b;
}
__device__ __forceinline__ void xcd_barrier_complete(unsigned* bar, unsigned x, unsigned& nloc, unsigned& nx) {
    const unsigned G = gridDim.x * gridDim.y * gridDim.z;
    unsigned sum, cnt, mine, sp = 0u;
    for (;;) {
        sum = 0u; cnt = 0u; mine = 0u;
#pragma unroll
        for (unsigned j = 0; j < 16; ++j) { const unsigned c = xb_ld(&bar[XB_XCNT(j)]); sum += c; cnt += (c > 0u) ? 1u : 0u; mine = (j == x) ? c : mine; }
        if (sum == G) break;
        __builtin_amdgcn_s_sleep(1);
        if ((++sp & 255u) == 0u) { if (xb_ld(&bar[XB_TMO])) break; if (sp > XB_SPIN_CAP) { atomicAdd(&bar[XB_TMO], 1u); break; } }
    }
    nloc = mine > 0u ? mine : 1u; nx = cnt > 0u ? cnt : 1u;
}

__device__ __forceinline__ void xcd_barrier(const XcdBarrier& b) {
    asm volatile("s_waitcnt vmcnt(0)" ::: "memory");
    __syncthreads();
    if (threadIdx.x == 0) {
        unsigned* bar = b.bar;
        __builtin_amdgcn_s_waitcnt(0);
        unsigned nloc = b.st[0], nx = b.st[1];
        if (nloc == 0u) { xcd_barrier_complete(bar, b.x, nloc, nx); b.st[0] = nloc; b.st[1] = nx; }
        const unsigned old = xb_add(&bar[XB_XSUB(b.x)], 1u);
        const unsigned gen = old / nloc;
        if (old + 1u == (gen + 1u) * nloc) {
            __builtin_amdgcn_fence(__ATOMIC_RELEASE, "agent");
            asm volatile("s_waitcnt vmcnt(0)" ::: "memory");
            const unsigned og = xb_add(&bar[XB_TOP], 1u);
            const unsigned tg = og / nx;
            if (og + 1u == (tg + 1u) * nx) xb_add(&bar[XB_TOPGEN], 1u);
            else XB_SPIN(xb_ld(&bar[XB_TOPGEN]) == tg, bar);
            __builtin_amdgcn_fence(__ATOMIC_ACQUIRE, "agent");
            xb_add(&bar[XB_XGEN(b.x)], 1u);
            asm volatile("s_waitcnt vmcnt(0)" ::: "memory");
        } else {
            XB_SPIN(xb_ld(&bar[XB_XGEN(b.x)]) == gen, bar);
            __builtin_amdgcn_fence(__ATOMIC_ACQUIRE, "agent");
            asm volatile("s_waitcnt vmcnt(0)" ::: "memory");
        }
    }
    __syncthreads();
}

typedef short bf16x8m __attribute__((ext_vector_type(8)));
#define MFMA16(a, b, c) __builtin_amdgcn_mfma_f32_16x16x32_bf16((a), (b), (c), 0, 0, 0)

constexpr int ML_QS = 0, ML_KS = 33792, ML_VS = 67584, ML_PS = 72704, ML_CT = 81920, ML_NS = 98816, ML_AS = 99840, ML_MS = 100096, ML_EM = 100352, ML_WK = 100608,
              ML_WI = 100864, ML_QN = 101120, ML_RS = 101376, ML_SC = 102400, ML_MP = 103680, ML_VW = 104448, ML_NPT = 109568;
constexpr int QROW = 528, VROW = 80, PROW = 144;
typedef short v4i16_t __attribute__((ext_vector_type(4)));
__device__ __forceinline__ v4i16_t ldtr(LAS const unsigned char* p) { return __builtin_amdgcn_ds_read_tr16_b64_v4i16((LAS v4i16_t*)p); }

__device__ __forceinline__ void gate_scan_task(const float* __restrict__ GT, f32x4v* __restrict__ GS, int task, int lane) {
    const int ck = task & 63, bh = task >> 6, b = bh >> 2, h = bh & 3;
    const size_t row = (size_t)b * 4096 + ck * 64 + lane;
    const float lf = GT[row * 8 + 4 + h], ig = GT[row * 8 + h];
    float bc = lf;
#pragma unroll
    for (int o = 1; o < 64; o <<= 1) { const float u = __shfl_up(bc, o); if (lane >= o) bc += u; }
    const float a = ig - bc;
    float cm = a;
#pragma unroll
    for (int o = 1; o < 64; o <<= 1) { const float u = __shfl_up(cm, o); if (lane >= o) cm = fmaxf(cm, u); }
    GS[(size_t)bh * 4096 + ck * 64 + lane] = (f32x4v){bc, a, cm, 0.f};
}

__device__ __forceinline__ void mlstm_unit(const Params& P, LAS unsigned char* lds, int unit) {
    const int tid = tid_fresh(), lane = tid & 63, w = tid >> 6, fr = lane & 15, fq = lane >> 4;
    const int b = unit >> 5, h = (unit >> 3) & 3, dvs = unit & 7;
    unsigned char* ws = P.ws;
    const size_t rowbase = (size_t)b * 4096;
    const bf16* Qg = (const bf16*)(ws + WS_QK) + rowbase * 2048 + h * 256;
    const bf16* Kg = Qg + 1024;
    const bf16* Vg = (const bf16*)(ws + WS_Z) + rowbase * NZ + ZMV + h * 256 + dvs * 32;
    const f32x4v* GS = (const f32x4v*)(ws + WS_GS) + (size_t)(b * 4 + h) * 4096;
    bf16* HB = (bf16*)(ws + WS_HBUF) + rowbase * DM + h * 256 + dvs * 32;
    float* SSQ = (float*)(ws + WS_SSQ) + (rowbase * 4 + h) * 16 + dvs * 2;
    LAS float* nS = (LAS float*)(lds + ML_NS); LAS float* aS = (LAS float*)(lds + ML_AS); LAS float* MS_ = (LAS float*)(lds + ML_MS); LAS float* emS = (LAS float*)(lds + ML_EM);
    LAS float* wkS = (LAS float*)(lds + ML_WK); LAS float* wiS = (LAS float*)(lds + ML_WI); LAS float* qnS = (LAS float*)(lds + ML_QN); LAS float* rsS = (LAS float*)(lds + ML_RS);
    LAS float* scS = (LAS float*)(lds + ML_SC); LAS float* mpS = (LAS float*)(lds + ML_MP);
    for (int i = tid; i < 32 * QROW / 4; i += 512) ((LAS unsigned*)(lds + ML_CT))[i] = 0u;
    if (tid < 256) nS[tid] = 0.f;
    if (w == 0) {
        const f32x4v gl = GS[lane * 64 + 63];
        float m = 0.f;
        for (int c = 0; c < 64; ++c) { const float bl = __shfl(gl[0], c), cl = __shfl(gl[2], c); if (lane == c) mpS[c] = m; m = bl + fmaxf(m, cl); }
        if (lane == 0) mpS[64] = m;
    }
    pg8::f32x4 Cacc[2][2];
#pragma unroll
    for (int a = 0; a < 2; ++a)
#pragma unroll
        for (int c = 0; c < 2; ++c) Cacc[a][c] = (pg8::f32x4){0.f, 0.f, 0.f, 0.f};
    const int mt = w >> 1;
#define ML_BAR() do { asm volatile("s_waitcnt lgkmcnt(0)" ::: "memory"); __builtin_amdgcn_s_barrier(); asm volatile("" ::: "memory"); } while (0)
    u32x4v pq[4], pk[4], pv; f32x4v pg; float pgr_a, pgl_cm;
    const int q4 = fr >> 2, p4 = fr & 3;
    const int trv = (8 * fq + q4) * VROW + 8 * p4;
    const int trk = (8 * fq + q4) * QROW + 8 * p4;
#define ML_PREFETCH(CK) do { const int t0_ = (CK) * 64; \
        _Pragma("unroll") for (int i = 0; i < 4; ++i) { const int idx = tid + 512 * i, r = idx >> 5, c = idx & 31; \
            pq[i] = *(const u32x4v*)(Qg + (size_t)(t0_ + r) * 2048 + c * 8); pk[i] = *(const u32x4v*)(Kg + (size_t)(t0_ + r) * 2048 + c * 8); } \
        if (tid < 256) { const int r = tid >> 2, c = tid & 3; pv = *(const u32x4v*)(Vg + (size_t)(t0_ + r) * NZ + c * 8); pgr_a = ((const float*)(GS + t0_ + r))[1]; pgl_cm = ((const float*)(GS + t0_ + 63))[2]; } \
        if (w == 0) pg = GS[t0_ + lane]; } while (0)
#define ML_COMMIT(CK) do { const float mp_ = mpS[(CK)]; \
        _Pragma("unroll") for (int i = 0; i < 4; ++i) { const int idx = tid + 512 * i, r = idx >> 5, c = idx & 31; \
            *(LAS u32x4v*)(lds + ML_QS + r * QROW + c * 16) = pq[i]; *(LAS u32x4v*)(lds + ML_KS + r * QROW + c * 16) = pk[i]; } \
        if (tid < 256) { const int r = tid >> 2, c = tid & 3; *(LAS u32x4v*)(lds + ML_VS + r * VROW + c * 16) = pv; \
            const float wk_ = exp_(pgr_a - fmaxf(mp_, pgl_cm)); u32x4v sv; \
            sv.x = pk2(bflo(pv.x) * wk_, bfhi(pv.x) * wk_); sv.y = pk2(bflo(pv.y) * wk_, bfhi(pv.y) * wk_); sv.z = pk2(bflo(pv.z) * wk_, bfhi(pv.z) * wk_); sv.w = pk2(bflo(pv.w) * wk_, bfhi(pv.w) * wk_); \
            *(LAS u32x4v*)(lds + ML_VW + r * VROW + c * 16) = sv; } \
        if (w == 0) { const float M_ = fmaxf(mp_, pg[2]); const float ML_ = __shfl(M_, 63); \
            aS[lane] = pg[1]; MS_[lane] = M_; emS[lane] = exp_(-(pg[0] + M_)); wkS[lane] = exp_(pg[1] - ML_); wiS[lane] = exp_(mp_ - M_); \
            if (lane == 0) scS[0] = exp_(mp_ - ML_); } } while (0)
    __syncthreads();
    ML_PREFETCH(0);
    ML_COMMIT(0);
    for (int ck = 0; ck < 64; ++ck) {
        const int t0 = ck * 64;
        ML_BAR();
        if (ck + 1 < 64) ML_PREFETCH(ck + 1);
        const int t = 16 * mt + fr;
        bf16x8m af[8];
        {
            const int ntb = (w & 1) * 2;
#pragma unroll
            for (int ks = 0; ks < 8; ++ks) af[ks] = *(const LAS bf16x8m*)(lds + ML_QS + (16 * mt + fr) * QROW + (32 * ks + 8 * fq) * 2);
            const float Mt = MS_[t];
            float as_[2][4];
#pragma unroll
            for (int nn = 0; nn < 2; ++nn)
#pragma unroll
                for (int i = 0; i < 4; ++i) as_[nn][i] = aS[16 * (ntb + nn) + 4 * fq + i];
            float qd = 0.f;
            {
                const int tt = tid >> 3, part = tid & 7;
#pragma unroll
                for (int c = 0; c < 4; ++c) { const u32x4v qv = *(const LAS u32x4v*)(lds + ML_QS + tt * QROW + (32 * part + 8 * c) * 2);
                    const f32x4v n0 = *(const LAS f32x4v*)(nS + 32 * part + 8 * c), n1 = *(const LAS f32x4v*)(nS + 32 * part + 8 * c + 4);
                    qd += bflo(qv.x) * n0[0] + bfhi(qv.x) * n0[1] + bflo(qv.y) * n0[2] + bfhi(qv.y) * n0[3] + bflo(qv.z) * n1[0] + bfhi(qv.z) * n1[1] + bflo(qv.w) * n1[2] + bfhi(qv.w) * n1[3]; }
            }
            __builtin_amdgcn_sched_barrier(0);
#pragma unroll
            for (int nn = 0; nn < 2; ++nn) {
                const int nt = ntb + nn;
                pg8::f32x4 acc = (pg8::f32x4){0.f, 0.f, 0.f, 0.f};
                float rsum = 0.f;
                if (nt <= mt) {
                    bf16x8m bfr[8];
#pragma unroll
                    for (int ks = 0; ks < 8; ++ks) bfr[ks] = *(const LAS bf16x8m*)(lds + ML_KS + (16 * nt + fr) * QROW + (32 * ks + 8 * fq) * 2);
                    __builtin_amdgcn_sched_barrier(0);
#pragma unroll
                    for (int ks = 0; ks < 8; ++ks) acc = MFMA16(bfr[ks], af[ks], acc);
#pragma unroll
                    for (int i = 0; i < 4; ++i) { const int s = 16 * nt + 4 * fq + i; const float p = (s <= t) ? acc[i] * exp_(as_[nn][i] - Mt) : 0.f; acc[i] = p; rsum += p; }
                }
                rsum = sum_x32(sum_x16(rsum));
                if (fq == 0) rsS[t * 4 + nt] = rsum;
                u32x2v pw; pw.x = pk2(acc[0], acc[1]); pw.y = pk2(acc[2], acc[3]);
                *(LAS u32x2v*)(lds + ML_PS + t * PROW + (16 * nt + 4 * fq) * 2) = pw;
            }
            qd = sum_grp8(qd);
            if ((tid & 7) == 0) qnS[tid >> 3] = qd;
        }
        ML_BAR();
        const int dt = w & 1;
        bf16x8m pa[2], vb[2], cb[8];
#pragma unroll
        for (int ks = 0; ks < 2; ++ks) {
            pa[ks] = *(const LAS bf16x8m*)(lds + ML_PS + (16 * mt + fr) * PROW + (32 * ks + 8 * fq) * 2);
            { const v4i16_t lo = ldtr(lds + ML_VS + 32 * ks * VROW + trv + 32 * dt), hi = ldtr(lds + ML_VS + (32 * ks + 4) * VROW + trv + 32 * dt); vb[ks] = __builtin_shufflevector(lo, hi, 0, 1, 2, 3, 4, 5, 6, 7); }
        }
#pragma unroll
        for (int ks = 0; ks < 8; ++ks) cb[ks] = *(const LAS bf16x8m*)(lds + ML_CT + (16 * dt + fr) * QROW + (32 * ks + 8 * fq) * 2);
        const float decay = scS[0];
        const float wi = wiS[t];
        const float den = (rsS[t * 4] + rsS[t * 4 + 1]) + (rsS[t * 4 + 2] + rsS[t * 4 + 3]) + wi * qnS[t];
        const float dn = fmaxf(fabsf(den), emS[t]);
        float npart[8];
        {
            const int dk8 = tid & 31, sl = tid >> 5;
#pragma unroll
            for (int j = 0; j < 8; ++j) npart[j] = 0.f;
#pragma unroll
            for (int r = 0; r < 4; ++r) { const u32x4v kv = *(const LAS u32x4v*)(lds + ML_KS + (4 * sl + r) * QROW + dk8 * 16); const float wkr = wkS[4 * sl + r];
                npart[0] += wkr * bflo(kv.x); npart[1] += wkr * bfhi(kv.x); npart[2] += wkr * bflo(kv.y); npart[3] += wkr * bfhi(kv.y);
                npart[4] += wkr * bflo(kv.z); npart[5] += wkr * bfhi(kv.z); npart[6] += wkr * bflo(kv.w); npart[7] += wkr * bfhi(kv.w); }
            *(LAS f32x4v*)(lds + ML_NPT + (sl * 256 + dk8 * 8) * 4) = (f32x4v){npart[0], npart[1], npart[2], npart[3]};
            *(LAS f32x4v*)(lds + ML_NPT + (sl * 256 + dk8 * 8 + 4) * 4) = (f32x4v){npart[4], npart[5], npart[6], npart[7]};
        }
        __builtin_amdgcn_sched_barrier(0);
        {
            pg8::f32x4 acc1 = (pg8::f32x4){0.f, 0.f, 0.f, 0.f}, acc2 = (pg8::f32x4){0.f, 0.f, 0.f, 0.f};
#pragma unroll
            for (int ks = 0; ks < 2; ++ks) acc1 = MFMA16(vb[ks], pa[ks], acc1);
#pragma unroll
            for (int ks = 0; ks < 8; ++ks) acc2 = MFMA16(cb[ks], af[ks], acc2);
            bf16x8m va[2][2], kb[2][2];
#pragma unroll
            for (int ks = 0; ks < 2; ++ks) {
#pragma unroll
                for (int dvt = 0; dvt < 2; ++dvt) { const v4i16_t lo = ldtr(lds + ML_VW + 32 * ks * VROW + trv + 32 * dvt), hi = ldtr(lds + ML_VW + (32 * ks + 4) * VROW + trv + 32 * dvt); va[dvt][ks] = __builtin_shufflevector(lo, hi, 0, 1, 2, 3, 4, 5, 6, 7); }
#pragma unroll
                for (int nk = 0; nk < 2; ++nk) { const v4i16_t lo = ldtr(lds + ML_KS + 32 * ks * QROW + trk + 32 * (2 * w + nk)), hi = ldtr(lds + ML_KS + (32 * ks + 4) * QROW + trk + 32 * (2 * w + nk)); kb[nk][ks] = __builtin_shufflevector(lo, hi, 0, 1, 2, 3, 4, 5, 6, 7); }
            }
#pragma unroll
            for (int dvt = 0; dvt < 2; ++dvt)
#pragma unroll
                for (int nk = 0; nk < 2; ++nk) {
                    pg8::f32x4 c = Cacc[dvt][nk] * decay;
#pragma unroll
                    for (int ks = 0; ks < 2; ++ks) c = MFMA16(kb[nk][ks], va[dvt][ks], c);
                    Cacc[dvt][nk] = c;
                }
            const float inv = __builtin_amdgcn_rcpf(dn);
            float hv[4]; float sq = 0.f;
#pragma unroll
            for (int i = 0; i < 4; ++i) { hv[i] = (acc1[i] + wi * acc2[i]) * inv; sq += hv[i] * hv[i]; }
            u32x2v hw; hw.x = pk2(hv[0], hv[1]); hw.y = pk2(hv[2], hv[3]);
            *(u32x2v*)(HB + (size_t)(t0 + t) * DM + 16 * dt + 4 * fq) = hw;
            sq = sum_x32(sum_x16(sq));
            if (fq == 0) SSQ[(size_t)(t0 + t) * 64 + dt] = sq;
        }
        ML_BAR();
#pragma unroll
        for (int dvt = 0; dvt < 2; ++dvt)
#pragma unroll
            for (int nk = 0; nk < 2; ++nk) { u32x2v cw; cw.x = pk2(Cacc[dvt][nk][0], Cacc[dvt][nk][1]); cw.y = pk2(Cacc[dvt][nk][2], Cacc[dvt][nk][3]);
                *(LAS u32x2v*)(lds + ML_CT + (16 * dvt + fr) * QROW + (16 * (2 * w + nk) + 4 * fq) * 2) = cw; }
        if (tid < 256) { float pv_[16];
#pragma unroll
            for (int sl = 0; sl < 16; ++sl) pv_[sl] = *(const LAS float*)(lds + ML_NPT + (sl * 256 + tid) * 4);
            const float nold = nS[tid];
            __builtin_amdgcn_sched_barrier(0);
            float s = 0.f;
#pragma unroll
            for (int sl = 0; sl < 16; ++sl) s += pv_[sl];
            nS[tid] = decay * nold + s; }
        if (ck + 1 < 64) ML_COMMIT(ck + 1);
    }
#undef ML_PREFETCH
#undef ML_COMMIT
#undef ML_BAR
    __syncthreads();
    {
        float* Cout = P.out + O_C_P + (size_t)(b * 4 + h) * 65536 + dvs * 32;
#pragma unroll
        for (int dvt = 0; dvt < 2; ++dvt)
#pragma unroll
            for (int nk = 0; nk < 2; ++nk)
#pragma unroll
                for (int i = 0; i < 4; ++i) Cout[(size_t)(16 * (2 * w + nk) + 4 * fq + i) * 256 + 16 * dvt + fr] = Cacc[dvt][nk][i];
        if (dvs == 0) { if (tid < 256) P.out[O_N_P + (size_t)(b * 4 + h) * 256 + tid] = nS[tid]; if (tid == 0) P.out[O_M_P + b * 4 + h] = mpS[64]; }
    }
    __syncthreads();
}

__device__ __forceinline__ void sample_mlstm_unit(const Params& P, LAS unsigned char* lds, int unit) {
    const int tid = tid_fresh(), lane = tid & 63, w = tid >> 6;
    const int b = unit >> 2, h = unit & 3;
    unsigned char* ws = P.ws;
    const size_t row = (size_t)MP + b;
    const bf16* Z = (const bf16*)(ws + WS_Z) + row * NZ;
    LAS float* qS = (LAS float*)lds; LAS float* kS = qS + 256; LAS float* vS = kS + 256; LAS float* red = vS + 256; LAS float* misc = red + 8 * 256;
    const float* sconv = P.in[5] + (size_t)b * 3 * 2048; const float* cw = P.in[13]; const float* cb = P.in[14];
    {
        const int j = tid & 255, col = (tid >> 8) * 1024 + h * 256 + j;
        float y = cb[col] + cw[col] * sconv[col] + cw[2048 + col] * sconv[2048 + col] + cw[2 * 2048 + col] * sconv[2 * 2048 + col] + cw[3 * 2048 + col] * bf2f(Z[ZMQ + col]);
        y = y * sigmoidf_(y);
        if (tid < 256) { qS[j] = y; vS[j] = bf2f(Z[ZMV + h * 256 + j]); } else kS[j] = y * 0.0625f;
    }
    const float* GT = (const float*)(ws + WS_GATES) + row * 8;
    const float ig = GT[h], lf = GT[4 + h], m0 = P.in[8][b * 4 + h];
    const float a = ig - lf, M = fmaxf(m0, a), m_new = lf + M, wk = exp_(a - M), decay = exp_(m0 - M);
    const float* n0 = P.in[7] + (size_t)(b * 4 + h) * 256;
    __syncthreads();
    float qk = 0.f, qn = 0.f;
#pragma unroll
    for (int c = 0; c < 4; ++c) { const int j = lane + 64 * c; qk += qS[j] * kS[j]; qn += qS[j] * n0[j]; }
    qk = wave_sum(qk); qn = wave_sum(qn);
    {
        const float* C0 = P.in[6] + (size_t)(b * 4 + h) * 65536; float* C1 = P.out + O_C_S + (size_t)(b * 4 + h) * 65536;
        const int c4 = lane * 4;
        const f32x4v v4 = *(const LAS f32x4v*)(vS + c4);
        f32x4v acc = (f32x4v){0.f, 0.f, 0.f, 0.f};
#pragma unroll 4
        for (int r = 0; r < 32; ++r) {
            const int dk = w * 32 + r;
            const f32x4v c0 = *(const f32x4v*)(C0 + (size_t)dk * 256 + c4);
            acc = acc + c0 * qS[dk];
            *(f32x4v*)(C1 + (size_t)dk * 256 + c4) = c0 * decay + v4 * (wk * kS[dk]);
        }
        *(LAS f32x4v*)(red + w * 256 + c4) = acc;
    }
    __syncthreads();
    float hval = 0.f;
    if (tid < 256) {
        float qc = 0.f;
#pragma unroll
        for (int r = 0; r < 8; ++r) qc += red[r * 256 + tid];
        const float num = qk * wk * vS[tid] + decay * qc, den = qk * wk + decay * qn;
        hval = num / fmaxf(fabsf(den), exp_(-m_new));
        const float s = wave_sum(hval * hval);
        if (lane == 0) misc[w] = s;
        P.out[O_N_S + (size_t)(b * 4 + h) * 256 + tid] = decay * n0[tid] + wk * kS[tid];
        if (tid == 0) P.out[O_M_S + b * 4 + h] = m_new;
    }
    __syncthreads();
    if (tid < 256) {
        const float ssq = (misc[0] + misc[1]) + (misc[2] + misc[3]);
        const float hm = hval * __builtin_amdgcn_rsqf(ssq * (1.0f / 256.0f) + EPSN) * P.in[17][h * 256 + tid];
        ((bf16*)(ws + WS_SOB))[(size_t)b * 1024 + h * 256 + tid] = (bf16)f2bf(hm * sigmoidf_(bf2f(Z[ZMO + h * 256 + tid])));
    }
    __syncthreads();
}

template <int W> __device__ __forceinline__ void shift_copy(const float* __restrict__ src, float* __restrict__ dst, int wb, int nwb) {
    constexpr unsigned per_b = (unsigned)(W - 1) * 128u, total = 32u * per_b;
    const f32x4v* s4 = (const f32x4v*)src; f32x4v* d4 = (f32x4v*)dst;
    const unsigned tid = (unsigned)tid_fresh();
    for (unsigned e0 = (unsigned)wb * 4096u + tid; e0 < total; e0 += (unsigned)nwb * 4096u) {
        f32x4v v[8]; unsigned off[8];
#pragma unroll
        for (int u = 0; u < 8; ++u) { const unsigned e = e0 + 512u * u; const unsigned b = e / per_b, x = e - b * per_b; off[u] = b * (unsigned)(W * 128) + x;
            if (e < total) v[u] = __builtin_nontemporal_load(s4 + off[u] + 128); }
#pragma unroll
        for (int u = 0; u < 8; ++u) { const unsigned e = e0 + 512u * u; if (e < total) __builtin_nontemporal_store(v[u], d4 + off[u]); }
    }
}

__device__ __forceinline__ void phase2b(const Params& P, LAS unsigned char* lds, int G) {
    const int nm = G >= 256 ? 128 : (G / 2 > 0 ? G / 2 : 1);
    if ((int)blockIdx.x < nm) {
#pragma nounroll
        for (int rep = 0, nrep = opaque_s(REP_ML); rep < nrep; ++rep)
            for (int u = blockIdx.x; u < 128; u += nm) mlstm_unit(P, lds, nm == 128 ? ((((u & 7) * 2 + (u >> 6)) << 3) | ((u >> 3) & 7)) : u);
    }
    if (G == 1 || (int)blockIdx.x >= nm) {
        const int wb = G == 1 ? 0 : blockIdx.x - nm, nwb = G == 1 ? 1 : G - nm;
#pragma nounroll
        for (int rep = 0, nrep = opaque_s(REP_CP); rep < nrep; ++rep) {
            attention_work(P, lds, wb * 8 + (tid_fresh() >> 6), nwb * 8);
            __syncthreads();
            for (int u = wb; u < 128; u += nwb) sample_mlstm_unit(P, lds, u);
            convert_weights(P, lds, wb * 8 + (tid_fresh() >> 6), nwb * 8, 16 * 264, W_ITEMS_ALL);
            __syncthreads();
            shift_copy<128>(P.in[2], P.out + O_KV128_S, wb, nwb);
            shift_copy<512>(P.in[3], P.out + O_KV512_S, wb, nwb);
            shift_copy<2048>(P.in[4], P.out + O_KV2048_S, wb, nwb);
        }
    }
}

__device__ __forceinline__ void phase_e2(const Params& P, int G) {
    unsigned char* ws = P.ws; const int tid = tid_fresh();
    const bf16* OG = (const bf16*)(ws + WS_OG); const float* LSE = (const float*)(ws + WS_LSE); bf16* OAB = (bf16*)(ws + WS_QK);
    for (int idx = blockIdx.x * 512 + tid; idx < MT * 32; idx += G * 512) {
        const int row = idx >> 5, c = (idx & 31) * 8, h = c >> 6;
        const float l0 = LSE[((size_t)0 * MPAD + row) * 4 + h], l1 = LSE[((size_t)1 * MPAD + row) * 4 + h], l2 = LSE[((size_t)2 * MPAD + row) * 4 + h];
        const float mx = fmaxf(l0, fmaxf(l1, l2)); float w0 = exp_(l0 - mx), w1 = exp_(l1 - mx), w2 = exp_(l2 - mx); const float inv = 1.0f / (w0 + w1 + w2); w0 *= inv; w1 *= inv; w2 *= inv;
        const u32x4v a = *(const u32x4v*)(OG + ((size_t)0 * MPAD + row) * 256 + c), bq = *(const u32x4v*)(OG + ((size_t)1 * MPAD + row) * 256 + c), cq = *(const u32x4v*)(OG + ((size_t)2 * MPAD + row) * 256 + c);
        u32x4v o;
        o.x = pk2(w0 * bflo(a.x) + w1 * bflo(bq.x) + w2 * bflo(cq.x), w0 * bfhi(a.x) + w1 * bfhi(bq.x) + w2 * bfhi(cq.x));
        o.y = pk2(w0 * bflo(a.y) + w1 * bflo(bq.y) + w2 * bflo(cq.y), w0 * bfhi(a.y) + w1 * bfhi(bq.y) + w2 * bfhi(cq.y));
        o.z = pk2(w0 * bflo(a.z) + w1 * bflo(bq.z) + w2 * bflo(cq.z), w0 * bfhi(a.z) + w1 * bfhi(bq.z) + w2 * bfhi(cq.z));
        o.w = pk2(w0 * bflo(a.w) + w1 * bflo(bq.w) + w2 * bflo(cq.w), w0 * bfhi(a.w) + w1 * bfhi(bq.w) + w2 * bfhi(cq.w));
        *(u32x4v*)(OAB + (size_t)row * KMIX + c) = o;
    }
    const bf16* HBm = (const bf16*)(ws + WS_HBUF); const float* SSQ = (const float*)(ws + WS_SSQ); const bf16* Z = (const bf16*)(ws + WS_Z); const float* mh = P.in[17];
    for (int idx = blockIdx.x * 512 + tid; idx < MP * 64; idx += G * 512) {
        const int row = idx >> 6, c0 = (idx & 63) * 16, h = c0 >> 8;
        const f32x4v* sp = (const f32x4v*)(SSQ + ((size_t)row * 4 + h) * 16);
        const f32x4v s0 = sp[0], s1 = sp[1], s2 = sp[2], s3 = sp[3];
        u32x4v hv[2], zo[2]; f32x4v g0[2], g1[2];
#pragma unroll
        for (int q = 0; q < 2; ++q) { const int c = c0 + 8 * q; hv[q] = *(const u32x4v*)(HBm + (size_t)row * DM + c); zo[q] = *(const u32x4v*)(Z + (size_t)row * NZ + ZMO + c); g0[q] = *(const f32x4v*)(mh + c); g1[q] = *(const f32x4v*)(mh + c + 4); }
        const float tot = ((s0[0] + s0[1]) + (s0[2] + s0[3])) + ((s1[0] + s1[1]) + (s1[2] + s1[3])) + ((s2[0] + s2[1]) + (s2[2] + s2[3])) + ((s3[0] + s3[1]) + (s3[2] + s3[3]));
        const float r = __builtin_amdgcn_rsqf(tot * (1.0f / 256.0f) + EPSN);
#pragma unroll
        for (int q = 0; q < 2; ++q) {
            u32x4v o;
            o.x = pk2(bflo(hv[q].x) * r * g0[q][0] * sigmoidf_(bflo(zo[q].x)), bfhi(hv[q].x) * r * g0[q][1] * sigmoidf_(bfhi(zo[q].x)));
            o.y = pk2(bflo(hv[q].y) * r * g0[q][2] * sigmoidf_(bflo(zo[q].y)), bfhi(hv[q].y) * r * g0[q][3] * sigmoidf_(bfhi(zo[q].y)));
            o.z = pk2(bflo(hv[q].z) * r * g1[q][0] * sigmoidf_(bflo(zo[q].z)), bfhi(hv[q].z) * r * g1[q][1] * sigmoidf_(bfhi(zo[q].z)));
            o.w = pk2(bflo(hv[q].w) * r * g1[q][2] * sigmoidf_(bflo(zo[q].w)), bfhi(hv[q].w) * r * g1[q][3] * sigmoidf_(bfhi(zo[q].w)));
            *(u32x4v*)(OAB + (size_t)row * KMIX + 256 + c0 + 8 * q) = o;
        }
    }
    const bf16* SOB = (const bf16*)(ws + WS_SOB);
    for (int idx = blockIdx.x * 512 + tid; idx < MS * 128; idx += G * 512) { const int b = idx >> 7, c = (idx & 127) * 8; *(u32x4v*)(OAB + (size_t)(MP + b) * KMIX + 256 + c) = *(const u32x4v*)(SOB + (size_t)b * 1024 + c); }
}

__device__ __forceinline__ void phase8(const Params& P, int G) {
    unsigned char* ws = P.ws; const int tid = tid_fresh();
    const bf16* H3 = (const bf16*)(ws + WS_XN); const float* ss3 = (const float*)(ws + WS_SS3); const float* nf = P.in[28];
    for (int idx = blockIdx.x * 512 + tid; idx < MT * 64; idx += G * 512) {
        const int row = idx >> 6, c0 = (idx & 63) * 16;
        const float rs = pg8::row_rs(ss3, row);
        u32x4v hv[2]; f32x4v g0[2], g1[2];
#pragma unroll
        for (int q = 0; q < 2; ++q) { const int c = c0 + 8 * q; hv[q] = *(const u32x4v*)(H3 + (size_t)row * DM + c); g0[q] = *(const f32x4v*)(nf + c); g1[q] = *(const f32x4v*)(nf + c + 4); }
        float* dst = row < MP ? P.out + O_Y_P + (size_t)row * DM + c0 : P.out + O_Y_S + (size_t)(row - MP) * DM + c0;
#pragma unroll
        for (int q = 0; q < 2; ++q) {
            *(f32x4v*)(dst + 8 * q) = (f32x4v){bflo(hv[q].x) * rs * g0[q][0], bfhi(hv[q].x) * rs * g0[q][1], bflo(hv[q].y) * rs * g0[q][2], bfhi(hv[q].y) * rs * g0[q][3]};
            *(f32x4v*)(dst + 8 * q + 4) = (f32x4v){bflo(hv[q].z) * rs * g1[q][0], bfhi(hv[q].z) * rs * g1[q][1], bflo(hv[q].w) * rs * g1[q][2], bfhi(hv[q].w) * rs * g1[q][3]};
        }
    }
}

__device__ __forceinline__ float thin_dot(const bf16* __restrict__ a, const bf16* __restrict__ b, int kq) {
    float s0 = 0.f, s1 = 0.f;
#pragma unroll 4
    for (int k = 0; k < kq; k += 8) {
        const u32x4v x = *(const u32x4v*)(a + k), y = *(const u32x4v*)(b + k);
        s0 += bflo(x.x) * bflo(y.x) + bflo(x.y) * bflo(y.y) + bflo(x.z) * bflo(y.z) + bflo(x.w) * bflo(y.w);
        s1 += bfhi(x.x) * bfhi(y.x) + bfhi(x.y) * bfhi(y.y) + bfhi(x.z) * bfhi(y.z) + bfhi(x.w) * bfhi(y.w);
    }
    float s = s0 + s1;
    s += __shfl_xor(s, 1); s += __shfl_xor(s, 2);
    return s;
}
__device__ __forceinline__ void thin_phase(const Params& P, int which, int G) {
    unsigned char* ws = P.ws;
    const int tid = tid_fresh(), r = tid >> 4, c = (tid >> 2) & 3, kq = tid & 3;
    const size_t row = (size_t)MP + r;
    const bf16* Z = (const bf16*)(ws + WS_Z); bf16* HBb = (bf16*)(ws + WS_HBUF);
    for (int col = blockIdx.x * 4 + c; col < DM; col += G * 4) {
        if (which == 3) {
            const bf16* oab = (const bf16*)(ws + WS_QK) + row * KMIX;
            const float dA = thin_dot(oab + kq * 64, (const bf16*)(ws + WS_WA) + (size_t)col * KMIX + kq * 64, 64);
            const float dB = thin_dot(oab + 256 + kq * 256, (const bf16*)(ws + WS_WA) + (size_t)col * KMIX + 256 + kq * 256, 256);
            if (kq == 0) ((bf16*)(ws + WS_XN))[row * DM + col] = (bf16)f2bf(sigmoidf_(bf2f(Z[row * NZ + ZGA + col])) * dA + sigmoidf_(bf2f(Z[row * NZ + ZGB + col])) * dB);
        } else if (which == 4 || which == 6) {
            float dd, base; float* ss;
            if (which == 4) { dd = thin_dot((const bf16*)(ws + WS_XN) + row * DM + kq * 256, (const bf16*)(ws + WS_WO) + (size_t)col * DM + kq * 256, 256); base = P.in[1][(size_t)r * DM + col]; ss = (float*)(ws + WS_SS1); }
            else { dd = thin_dot((const bf16*)(ws + WS_ACT) + row * DFF + kq * 704, (const bf16*)(ws + WS_WD) + (size_t)col * DFF + kq * 704, 704); base = bf2f(HBb[row * DM + col]); ss = (float*)(ws + WS_SS2); }
            const float hv = base + dd;
            float sq = hv * hv; sq += __shfl_xor(sq, 4); sq += __shfl_xor(sq, 8);
            if (kq == 0) { HBb[row * DM + col] = (bf16)f2bf(hv); if (c == 0) atomicAdd(ss + row * 16, sq); }
        } else {
            const float dp = thin_dot((const bf16*)(ws + WS_PB) + row * 256 + kq * 64, (const bf16*)(ws + WS_WPP) + (size_t)col * 256 + kq * 64, 64);
            const float dg = thin_dot(HBb + row * DM + kq * 256, (const bf16*)(ws + WS_WPG) + (size_t)col * DM + kq * 256, 256);
            const float rs = pg8::row_rs((const float*)(ws + WS_SS2), (int)row);
            const float hv = bf2f(HBb[row * DM + col]) + sigmoidf_(rs * dg) * dp;
            float sq = hv * hv; sq += __shfl_xor(sq, 4); sq += __shfl_xor(sq, 8);
            if (kq == 0) { ((bf16*)(ws + WS_XN))[row * DM + col] = (bf16)f2bf(hv); if (c == 0) atomicAdd((float*)(ws + WS_SS3) + row * 16, sq); }
        }
    }
}

__global__ void __launch_bounds__(512) hybrid_step_fwd(Params P) {
    extern __shared__ __attribute__((aligned(16))) unsigned char lds_raw[];
    LAS unsigned char* lds = (LAS unsigned char*)lds_raw;
    cg::grid_group grid = cg::this_grid();
    const int G = gridDim.x;
    unsigned char* ws = P.ws;
    unsigned* barw = (unsigned*)(ws + WS_BAR);
    volatile LAS unsigned* xst = (volatile LAS unsigned*)(lds + LDS_BYTES - 64);
    { const int t0_ = tid_fresh(); if (t0_ < 2) xst[t0_] = 0u; if (blockIdx.x == 0) for (int i = t0_; i < XCD_BAR_WORDS; i += 512) barw[i] = 0u; }
#pragma nounroll
    for (int rep = 0, nrep = opaque_s(REP_P0); rep < nrep; ++rep) {
        phase0(P, lds, G);
        grid.sync();
    }
    const XcdBarrier xb = xcd_barrier_post(barw, xst);
#define GSYNC() do { _Pragma("nounroll") for (int r_ = 0, nr_ = opaque_s(REP_SYNC); r_ < nr_; ++r_) xcd_barrier(xb); } while (0)
#pragma nounroll
    for (int rep = 0, nrep = opaque_s(REP_P1); rep < nrep; ++rep) {
        pg8::Gemm g{(const bf16*)(ws + WS_XN), (const bf16*)(ws + WS_WIN), MPAD, NZ, DM, DM, DM}; pg8::StaticOrder S; S.init(MPAD, NZ, G, (int)blockIdx.x);
        pg8::EpiZ E{(bf16*)(ws + WS_Z), (bf16*)(ws + WS_VT), (const float*)(ws + WS_ROPE), P.out};
        pg8::gemm_phase<pg8::EpiZ, pg8::StaticOrder, true, true>(lds, g, S, E);
        GSYNC();
    }
#pragma nounroll
    for (int rep = 0, nrep = opaque_s(REP_P2A); rep < nrep; ++rep) {
        phase2a(P, lds, G);
        GSYNC();
    }
#pragma nounroll
    for (int rep = 0, nrep = opaque_s(REP_P2B); rep < nrep; ++rep) {
        phase2b(P, lds, G);
        GSYNC();
    }
#pragma nounroll
    for (int rep = 0, nrep = opaque_s(REP_E2); rep < nrep; ++rep) {
        phase_e2(P, G);
        GSYNC();
    }
#pragma nounroll
    for (int rep = 0, nrep = opaque_s(REP_P3); rep < nrep; ++rep) {
        pg8::StaticOrder S; S.init(MP, DM, G, (int)blockIdx.x);
        pg8::Gemm g{(const bf16*)(ws + WS_QK), (const bf16*)(ws + WS_WA), MP, DM, KMIX, KMIX, KMIX};
        pg8::EpiMix E{(const bf16*)(ws + WS_Z), (bf16*)(ws + WS_XN)};
        pg8::gemm_phase<pg8::EpiMix, pg8::StaticOrder, true, true>(lds, g, S, E);
        thin_phase(P, 3, G);
        GSYNC();
    }
#pragma nounroll
    for (int rep = 0, nrep = opaque_s(REP_P4); rep < nrep; ++rep) {
        pg8::StaticOrder S; S.init(MP, DM, G, (int)blockIdx.x);
        pg8::Gemm g{(const bf16*)(ws + WS_XN), (const bf16*)(ws + WS_WO), MP, DM, DM, DM, DM};
        pg8::EpiRes E{P.in[0], (bf16*)(ws + WS_HBUF), (float*)(ws + WS_SS1), 0};
        pg8::gemm_phase<pg8::EpiRes, pg8::StaticOrder, true, true>(lds, g, S, E);
        thin_phase(P, 4, G);
        GSYNC();
    }
#pragma nounroll
    for (int rep = 0, nrep = opaque_s(REP_P5); rep < nrep; ++rep) {
        pg8::StaticOrder S; S.init(MPAD, NGU, G, (int)blockIdx.x);
        pg8::Gemm g{(const bf16*)(ws + WS_HBUF), (const bf16*)(ws + WS_WGU), MPAD, NGU, DM, DM, DM};
        pg8::EpiGU E{(const float*)(ws + WS_SS1), (bf16*)(ws + WS_ACT)};
        pg8::gemm_phase<pg8::EpiGU, pg8::StaticOrder, true, true>(lds, g, S, E);
        GSYNC();
    }
    {
        pg8::StaticOrder S; S.init(MP, DM, G, (int)blockIdx.x);
        pg8::Gemm g{(const bf16*)(ws + WS_ACT), (const bf16*)(ws + WS_WD), MP, DM, DFF, DFF, DFF};
        pg8::EpiRes E{nullptr, (bf16*)(ws + WS_HBUF), (float*)(ws + WS_SS2), 1};
        pg8::gemm_phase<pg8::EpiRes, pg8::StaticOrder, true, true>(lds, g, S, E);
        thin_phase(P, 6, G);
        GSYNC();
    }
    {
        pg8::StaticOrder S; S.init(MP, DM, G, (int)blockIdx.x);
#pragma nounroll
        for (int pass = 0; pass < 2; ++pass) {
            int ps = pass; asm volatile("" : "+s"(ps));
            pg8::Gemm g{(const bf16*)(ws + (ps ? WS_HBUF : WS_PB)), (const bf16*)(ws + (ps ? WS_WPG : WS_WPP)), MP, DM, ps ? DM : 256, ps ? DM : 256, ps ? DM : 256};
            pg8::EpiPle E{(const float*)(ws + WS_SS2), (bf16*)(ws + WS_PP), (const bf16*)(ws + WS_HBUF), (bf16*)(ws + WS_XN), (float*)(ws + WS_SS3), ps};
            pg8::gemm_phase<pg8::EpiPle, pg8::StaticOrder, true, true>(lds, g, S, E);
        }
        thin_phase(P, 7, G);
        GSYNC();
    }
#pragma nounroll
    for (int rep = 0, nrep = opaque_s(REP_P8); rep < nrep; ++rep) phase8(P, G);
}

extern "C" void kernel_launch(void* const* d_in, const int* in_sizes, int n_in, void* d_out, int out_size, void* d_ws, size_t ws_size, hipStream_t stream) {
    static int grid_blocks = 0;
    if (!grid_blocks) {
        int dev = 0, cus = 0, per_cu = 0;
        (void)hipGetDevice(&dev);
        (void)hipDeviceGetAttribute(&cus, hipDeviceAttributeMultiprocessorCount, dev);
        (void)hipFuncSetAttribute((const void*)hybrid_step_fwd, hipFuncAttributeMaxDynamicSharedMemorySize, LDS_BYTES);
        (void)hipOccupancyMaxActiveBlocksPerMultiprocessor(&per_cu, (const void*)hybrid_step_fwd, 512, LDS_BYTES);
        if (per_cu < 1) per_cu = 1;
        grid_blocks = cus * per_cu;
        if (n_in != 29 || (size_t)out_size != O_END || ws_size < WS_END) { fprintf(stderr, "kernel_launch: unexpected sizes n_in %d out %d ws %zu (need %zu)\n", n_in, out_size, ws_size, (size_t)WS_END); grid_blocks = -1; }
    }
    if (grid_blocks < 0) return;
    Params p{};
    for (int i = 0; i < 29; ++i) p.in[i] = (const float*)d_in[i];
    p.out = (float*)d_out; p.ws = (unsigned char*)d_ws;
    void* args[] = {&p};
    hipError_t e = hipLaunchCooperativeKernel((void*)hybrid_step_fwd, dim3(grid_blocks), dim3(512), args, LDS_BYTES, stream);
    if (e != hipSuccess) fprintf(stderr, "cooperative launch failed: %s (grid %d)\n", hipGetErrorString(e), grid_blocks);
}
```

```cpp
#include <hip/hip_runtime.h>
#include <hip/hip_cooperative_groups.h>
#include <cstdio>
#include <cstdint>
namespace cg = cooperative_groups;
#define REP_SYNC 1
#define REP_P0 1
#define REP_P1 1
#define REP_P2A 1
#define REP_P2B 1
#define REP_ML 1
#define REP_CP 1
#define REP_VT 1
#define REP_EPZ 1
#define REP_SA 1
#define REP_AT 1
#define REP_CV 1
#define REP_E2 1
#define REP_P3 1
#define REP_P4 1
#define REP_P5 1
#define REP_P8 1

constexpr int MP = 16384, MS = 32, MT = MP + MS, MPAD = 16640;
constexpr int DM = 1024, SEQ = 4096, NZ = 8448, DFF = 2816, NGU = 2 * DFF, KMIX = 1280;
constexpr int ZQ = 0, ZK = 768, ZV = 1536, ZMQ = 2304, ZMK = 3328, ZMV = 4352, ZMO = 5376, ZGA = 6400, ZGB = 7424;
constexpr float EPSN = 1e-6f;
constexpr float LOG2E = 1.4426950408889634f, LN2 = 0.6931471805599453f;
constexpr float QSCALE = 0.125f * LOG2E;

constexpr size_t O_Y_P = 0, O_Y_S = O_Y_P + (size_t)MP * DM, O_KV128_P = O_Y_S + (size_t)MS * DM, O_KV128_S = O_KV128_P + 4 * 128 * 512,
                 O_KV512_P = O_KV128_S + 32 * 128 * 512, O_KV512_S = O_KV512_P + 4 * 512 * 512, O_KV2048_P = O_KV512_S + 32 * 512 * 512,
                 O_KV2048_S = O_KV2048_P + 4 * 2048 * 512, O_CONV_P = O_KV2048_S + (size_t)32 * 2048 * 512, O_CONV_S = O_CONV_P + 4 * 3 * 2048,
                 O_C_P = O_CONV_S + 32 * 3 * 2048, O_C_S = O_C_P + 16 * 65536, O_N_P = O_C_S + 128 * 65536, O_N_S = O_N_P + 16 * 256,
                 O_M_P = O_N_S + 128 * 256, O_M_S = O_M_P + 16, O_END = O_M_S + 128;

constexpr size_t al256(size_t x) { return (x + 255) & ~(size_t)255; }
constexpr size_t WS_WIN = 0;
constexpr size_t WS_WA = WS_WIN + (size_t)NZ * DM * 2;
constexpr size_t WS_WB = WS_WA + (size_t)DM * 256 * 2;
constexpr size_t WS_WO = WS_WB + (size_t)DM * DM * 2;
constexpr size_t WS_WGU = WS_WO + (size_t)DM * DM * 2;
constexpr size_t WS_WD = WS_WGU + (size_t)NGU * DM * 2;
constexpr size_t WS_WPG = WS_WD + (size_t)DM * DFF * 2;
constexpr size_t WS_WPP = WS_WPG + (size_t)DM * DM * 2;
constexpr size_t WS_GATES = WS_WPP + (size_t)DM * 256 * 2;
constexpr size_t WS_ROPE = al256(WS_GATES + (size_t)MT * 8 * 4);
constexpr size_t WS_PB = al256(WS_ROPE + (size_t)4097 * 16 * 4);
constexpr size_t WS_LSE = WS_PB + (size_t)MPAD * 256 * 2;
constexpr size_t WS_SSQ = WS_LSE + (size_t)3 * MPAD * 4 * 4;
constexpr size_t WS_SS1 = WS_SSQ + (size_t)MP * 64 * 4;
constexpr size_t WS_SS2 = WS_SS1 + (size_t)MPAD * 16 * 4;
constexpr size_t WS_SS3 = WS_SS2 + (size_t)MPAD * 16 * 4;
constexpr size_t WS_SOB = WS_SS3 + (size_t)MPAD * 16 * 4;
constexpr size_t WS_BAR = WS_SOB + (size_t)32 * 1024 * 2;
constexpr size_t WS_GS = WS_BAR + 16384;
constexpr size_t WS_XN = WS_GS + (size_t)16 * 4096 * 16;
constexpr size_t WS_VT = WS_XN + (size_t)MPAD * DM * 2;
constexpr size_t WS_OG = WS_VT + (size_t)4 * 12 * 64 * 4096 * 2;
constexpr size_t WS_QK = WS_OG + (size_t)3 * MPAD * 256 * 2;
constexpr size_t WS_HBUF = WS_QK + (size_t)MP * 2048 * 2;
constexpr size_t WS_Z = WS_HBUF + (size_t)MPAD * DM * 2;
constexpr size_t WS_HF = WS_Z;
constexpr size_t WS_ACT = WS_HF + (size_t)MPAD * DM * 4;
constexpr size_t WS_PP = WS_ACT + (size_t)MPAD * DFF * 2;
constexpr size_t WS_END = WS_Z + (size_t)MPAD * NZ * 2;
static_assert(WS_PP + (size_t)MPAD * DM * 4 <= WS_END, "overlay fits in z");
static_assert((size_t)MPAD * KMIX * 2 <= (size_t)MP * 2048 * 2, "o_ab fits in qk");
static_assert((size_t)MPAD * DM * 2 <= (size_t)(WS_QK - WS_VT), "mixA fits in vt|og");
static_assert(WS_END <= (size_t)512 * 1024 * 1024, "workspace");

constexpr int LDS_BYTES = 140 * 1024;
#define LAS __attribute__((address_space(3)))
typedef unsigned short bf16;
typedef float f32x4v __attribute__((ext_vector_type(4)));
typedef float f32x2v __attribute__((ext_vector_type(2)));
typedef unsigned u32x4v __attribute__((ext_vector_type(4)));
typedef unsigned u32x2v __attribute__((ext_vector_type(2)));
typedef short s16x8v __attribute__((ext_vector_type(8)));

__device__ __forceinline__ unsigned f2bf(float f) { unsigned u = __builtin_bit_cast(unsigned, f); return (u + 0x7fffu + ((u >> 16) & 1u)) >> 16; }
typedef __bf16 bf16x2_hw __attribute__((ext_vector_type(2)));
__device__ __forceinline__ unsigned pk2(float lo, float hi) { const f32x2v v = {lo, hi}; return __builtin_bit_cast(unsigned, __builtin_convertvector(v, bf16x2_hw)); }
__device__ __forceinline__ float sum_x16(float v) { return v + __shfl_xor(v, 16); }
__device__ __forceinline__ float sum_x32(float v) { return v + __shfl_xor(v, 32); }
__device__ __forceinline__ float max_x32(float v) { return fmaxf(v, __shfl_xor(v, 32)); }
__device__ __forceinline__ float sum_grp8(float v) {
    v += __builtin_bit_cast(float, __builtin_amdgcn_update_dpp(0, __builtin_bit_cast(int, v), 0xB1, 0xF, 0xF, true));
    v += __builtin_bit_cast(float, __builtin_amdgcn_update_dpp(0, __builtin_bit_cast(int, v), 0x4E, 0xF, 0xF, true));
    v += __builtin_bit_cast(float, __builtin_amdgcn_update_dpp(0, __builtin_bit_cast(int, v), 0x141, 0xF, 0xF, true));
    return v;
}
__device__ __forceinline__ float bf2f(unsigned short b) { return __builtin_bit_cast(float, (unsigned)b << 16); }
__device__ __forceinline__ float bflo(unsigned w) { return __builtin_bit_cast(float, w << 16); }
__device__ __forceinline__ float bfhi(unsigned w) { return __builtin_bit_cast(float, w & 0xffff0000u); }
__device__ __forceinline__ float sigmoidf_(float x) { return __builtin_amdgcn_rcpf(1.0f + __builtin_amdgcn_exp2f(-x * LOG2E)); }
__device__ __forceinline__ float exp_(float x) { return __builtin_amdgcn_exp2f(x * LOG2E); }
__device__ __forceinline__ float wave_sum(float v) {
#pragma unroll
    for (int o = 1; o < 64; o <<= 1) v += __shfl_xor(v, o);
    return v;
}
__device__ __forceinline__ float wave_max(float v) {
#pragma unroll
    for (int o = 1; o < 64; o <<= 1) v = fmaxf(v, __shfl_xor(v, o));
    return v;
}

__device__ __forceinline__ int tid_fresh() { int t = threadIdx.x; asm volatile("" : "+v"(t)); return t; }

__device__ __forceinline__ int opaque_s(int x) { asm volatile("" : "+s"(x)); return x; }

struct Params {
    const float* in[29];
    float* out;
    unsigned char* ws;
};
namespace pg8 {
#define PG8_LAS __attribute__((address_space(3)))
typedef unsigned short bf16_t;
typedef short bf16x8 __attribute__((ext_vector_type(8)));
typedef float f32x4 __attribute__((ext_vector_type(4)));
typedef unsigned u32x4 __attribute__((ext_vector_type(4)));
constexpr int BM = 256, BK = 64, HALF = 128, HTB = HALF * BK * 2  , STAGE_BYTES = 8 * HTB, NXCD = 8, WGM = 8;

__host__ __device__ __forceinline__ int lds_byte(int r, int c) { const int st = (r >> 4) * 2 + (c >> 5), rr = r & 15, cc = c & 31, ob = rr * 64 + cc * 2; return st * 1024 + (ob ^ (((ob >> 9) & 1) << 5)); }
__host__ __device__ __forceinline__ void stage_rc(int b, int& R, int& C) { const int st = b / 1024, sb = b % 1024, swz = sb ^ (((sb >> 9) & 1) << 5); R = (st >> 1) * 16 + swz / 64; C = (st & 1) * 32 + (swz % 64) / 2; }
__host__ __device__ __forceinline__ int perm32(int rho) { const int n = rho >> 4, i = rho & 15; return 8 * (i >> 2) + 4 * n + (i & 3); }

struct Unit { int pm, pn; };
struct Gemm { const bf16_t* A; const bf16_t* Bt; int M, N, K, lda, ldb; };

struct StaticOrder {
    int nM, nN, nwg, G, c;
    __host__ __device__ void init(int M, int N, int G_, int c_) { nM = M / BM; nN = N / BM; nwg = nM * nN; G = G_; c = c_; }
    __host__ __device__ bool next(int i, Unit& u) const {
        const long L = (long)i * G + c; if (L >= nwg) return false;
        int wgid = (int)L; { const int q = nwg / NXCD, r = nwg % NXCD, xcd = wgid % NXCD, off = wgid / NXCD; wgid = (xcd < r ? xcd * (q + 1) : r * (q + 1) + (xcd - r) * q) + off; }
        const int nig = WGM * nN, gid = wgid / nig, fm = gid * WGM, gsz = (nM - fm) < WGM ? (nM - fm) : WGM;
        u.pm = fm + ((wgid % nig) % gsz); u.pn = (wgid % nig) / gsz; return true;
    }
    __device__ __forceinline__ void a_ready(const Unit&) const {}
    __device__ __forceinline__ void done(const Unit&) const {}
};


__device__ __forceinline__ unsigned cvt_pk_bf16(float lo, float hi) { unsigned r; asm volatile("v_cvt_pk_bf16_f32 %0, %1, %2" : "=v"(r) : "v"(lo), "v"(hi)); return r; }
typedef unsigned u32x2 __attribute__((ext_vector_type(2)));

struct EpiZ {
    static constexpr bool PERM = true, AFTER_DRAIN = false, MID = false;
    bf16_t* Z; bf16_t* VT; const float* rope; float* out;
    __device__ __forceinline__ void operator()(const f32x4 (&acc)[2][2][4][2], const Unit& u, int wr, int wc, int fr, int fq) const {
        const int pn = u.pn;
        const bool do_rope = (pn < 6) && ((wc & 1) == 0);
        const bool is_kv = (pn >= 3 && pn < 9);
        const int kvsel = is_kv ? (pn - 3) / 3 : 0;
        const int g = is_kv ? (pn - 3) % 3 : 0;
        const int W = 128 << (2 * g);
        const size_t okp = g == 0 ? O_KV128_P : (g == 1 ? O_KV512_P : O_KV2048_P);
        const size_t oks = g == 0 ? O_KV128_S : (g == 1 ? O_KV512_S : O_KV2048_S);
        const bool is_conv = (pn >= 9 && pn < 17);
        const float sgn = fq == 0 ? -1.f : 1.f;
#pragma unroll
        for (int ai = 0; ai < 2; ++ai)
#pragma unroll
            for (int m = 0; m < 4; ++m) {
                const int row = u.pm * BM + ai * HALF + wr * 64 + m * 16 + fr;
                const bool isP = row < MP, isS = (row >= MP) && (row < MT);
                const int b = isP ? (row >> 12) : (row - MP);
                const int t = row & 4095;
                float cosv[8], sinv[8];
                if (do_rope) {
                    const f32x4* cs = (const f32x4*)(rope + (size_t)(isP ? t : 4096) * 16);
#pragma unroll
                    for (int q = 0; q < 4; ++q) { const f32x4 c = cs[q]; cosv[2 * q] = c[0]; sinv[2 * q] = c[1]; cosv[2 * q + 1] = c[2]; sinv[2 * q + 1] = c[3]; }
                }
#pragma unroll
                for (int bj = 0; bj < 2; ++bj) {
                    f32x4 v0 = acc[ai][bj][m][0], v1 = acc[ai][bj][m][1];
                    const int cit = bj * HALF + wc * 32 + fq * 8;
                    if (do_rope) {
#pragma unroll
                        for (int j = 0; j < 4; ++j) {
                            const float p0 = __shfl_xor(v0[j], 16), p1 = __shfl_xor(v1[j], 16);
                            const float r0 = v0[j] * cosv[j] + sgn * p0 * sinv[j], r1 = v1[j] * cosv[4 + j] + sgn * p1 * sinv[4 + j];
                            v0[j] = fq < 2 ? r0 : v0[j]; v1[j] = fq < 2 ? r1 : v1[j];
                        }
                    }
                    if (pn < 3) { v0 = v0 * QSCALE; v1 = v1 * QSCALE; }
                    u32x4 w; w.x = cvt_pk_bf16(v0[0], v0[1]); w.y = cvt_pk_bf16(v0[2], v0[3]); w.z = cvt_pk_bf16(v1[0], v1[1]); w.w = cvt_pk_bf16(v1[2], v1[3]);
                    *(u32x4*)(Z + (size_t)row * NZ + pn * BM + cit) = w;
                    if (is_kv) {
                        float* dst = nullptr;
                        if (isP && t >= 4096 - W) dst = out + okp + ((size_t)(b * W + t - (4096 - W)) * 2 + kvsel) * 256 + cit;
                        else if (isS) dst = out + oks + ((size_t)(b * W + W - 1) * 2 + kvsel) * 256 + cit;
                        if (dst) { *(f32x4*)dst = v0; *(f32x4*)(dst + 4) = v1; }
                    }
                    if (is_conv) {
                        const int cc = pn * BM + cit - ZMQ;
                        float* dst = nullptr;
                        if (isP && t >= 4093) dst = out + O_CONV_P + (size_t)(b * 3 + t - 4093) * 2048 + cc;
                        else if (isS) dst = out + O_CONV_S + (size_t)(b * 3 + 2) * 2048 + cc;
                        if (dst) { *(f32x4*)dst = v0; *(f32x4*)(dst + 4) = v1; }
                    }
                }
            }
    }
};

struct EpiMix {
    static constexpr bool PERM = true, AFTER_DRAIN = false, MID = true;
    static constexpr int MID_T = 4;
    const bf16_t* Z; bf16_t* MIX;
    __device__ __forceinline__ void mid(f32x4 (&acc)[2][2][4][2], const Unit& u, int wr, int wc, int fr, int fq) const {
        int row0 = u.pm * BM + wr * 64 + fr, col0 = u.pn * BM + wc * 32 + fq * 8;
        asm volatile("" : "+v"(row0), "+v"(col0));
#pragma unroll
        for (int ai = 0; ai < 2; ++ai)
#pragma unroll
            for (int m = 0; m < 4; ++m) {
                const int row = row0 + ai * HALF + m * 16;
#pragma unroll
                for (int bj = 0; bj < 2; ++bj) {
                    const int col = col0 + bj * HALF;
                    const u32x4 za = *(const u32x4*)(Z + (size_t)row * NZ + ZGA + col), zb = *(const u32x4*)(Z + (size_t)row * NZ + ZGB + col);
#define MIXR(a_, b_) ((1.0f + __builtin_amdgcn_exp2f(-(b_) * LOG2E)) * __builtin_amdgcn_rcpf(1.0f + __builtin_amdgcn_exp2f(-(a_) * LOG2E)))
                    acc[ai][bj][m][0][0] *= MIXR(bflo(za.x), bflo(zb.x)); acc[ai][bj][m][0][1] *= MIXR(bfhi(za.x), bfhi(zb.x));
                    acc[ai][bj][m][0][2] *= MIXR(bflo(za.y), bflo(zb.y)); acc[ai][bj][m][0][3] *= MIXR(bfhi(za.y), bfhi(zb.y));
                    acc[ai][bj][m][1][0] *= MIXR(bflo(za.z), bflo(zb.z)); acc[ai][bj][m][1][1] *= MIXR(bfhi(za.z), bfhi(zb.z));
                    acc[ai][bj][m][1][2] *= MIXR(bflo(za.w), bflo(zb.w)); acc[ai][bj][m][1][3] *= MIXR(bfhi(za.w), bfhi(zb.w));
#undef MIXR
                    asm volatile("" ::: "memory"); __builtin_amdgcn_sched_barrier(0);
                }
            }
    }
    __device__ __forceinline__ void operator()(const f32x4 (&acc)[2][2][4][2], const Unit& u, int wr, int wc, int fr, int fq) const {
#pragma unroll
        for (int ai = 0; ai < 2; ++ai)
#pragma unroll
            for (int m = 0; m < 4; ++m) {
                const int row = u.pm * BM + ai * HALF + wr * 64 + m * 16 + fr;
#pragma unroll
                for (int bj = 0; bj < 2; ++bj) {
                    const int col = u.pn * BM + bj * HALF + wc * 32 + fq * 8;
                    const u32x4 zg = *(const u32x4*)(Z + (size_t)row * NZ + ZGB + col);
                    const f32x4 v0 = acc[ai][bj][m][0], v1 = acc[ai][bj][m][1];
                    u32x4 w;
                    w.x = cvt_pk_bf16(v0[0] * sigmoidf_(bflo(zg.x)), v0[1] * sigmoidf_(bfhi(zg.x)));
                    w.y = cvt_pk_bf16(v0[2] * sigmoidf_(bflo(zg.y)), v0[3] * sigmoidf_(bfhi(zg.y)));
                    w.z = cvt_pk_bf16(v1[0] * sigmoidf_(bflo(zg.z)), v1[1] * sigmoidf_(bfhi(zg.z)));
                    w.w = cvt_pk_bf16(v1[2] * sigmoidf_(bflo(zg.w)), v1[3] * sigmoidf_(bfhi(zg.w)));
                    *(u32x4*)(MIX + (size_t)row * DM + col) = w;
                    asm volatile("" ::: "memory");
                }
            }
    }
};
struct EpiRes {
    static constexpr bool PERM = false, AFTER_DRAIN = false, MID = false;
    const float* xp; bf16_t* HB; float* ss; int mode;
    __device__ __forceinline__ void operator()(const f32x4 (&acc)[2][2][4][2], const Unit& u, int wr, int wc, int fr, int fq) const {
#pragma unroll
        for (int ai = 0; ai < 2; ++ai)
#pragma unroll
            for (int m = 0; m < 4; ++m) {
                const int row = u.pm * BM + ai * HALF + wr * 64 + m * 16 + fr;
                float s = 0.f;
#pragma unroll
                for (int bj = 0; bj < 2; ++bj)
#pragma unroll
                    for (int n = 0; n < 2; ++n) {
                        const int col = u.pn * BM + bj * HALF + wc * 32 + n * 16 + fq * 4;
                        f32x4 h = acc[ai][bj][m][n];
                        if (mode) { const u32x2 hb = *(const u32x2*)(HB + (size_t)row * DM + col); h[0] += bflo(hb.x); h[1] += bfhi(hb.x); h[2] += bflo(hb.y); h[3] += bfhi(hb.y); }
                        else h = h + *(const f32x4*)(xp + (size_t)row * DM + col);
                        u32x2 w; w.x = cvt_pk_bf16(h[0], h[1]); w.y = cvt_pk_bf16(h[2], h[3]);
                        *(u32x2*)(HB + (size_t)row * DM + col) = w;
                        s += (h[0] * h[0] + h[1] * h[1]) + (h[2] * h[2] + h[3] * h[3]);
                    }
                s = sum_x32(sum_x16(s));
                if (fq == 0) ss[(size_t)row * 16 + u.pn * 4 + wc] = s;
                asm volatile("" ::: "memory");
            }
    }
};
__device__ __forceinline__ float row_rs(const float* ss, int row) {
    const f32x4* sp = (const f32x4*)(ss + (size_t)row * 16);
    const f32x4 a = sp[0], b = sp[1], c = sp[2], d = sp[3];
    const float tot = ((a[0] + a[1]) + (a[2] + a[3])) + ((b[0] + b[1]) + (b[2] + b[3])) + ((c[0] + c[1]) + (c[2] + c[3])) + ((d[0] + d[1]) + (d[2] + d[3]));
    return __builtin_amdgcn_rsqf(tot * (1.0f / 1024.0f) + EPSN);
}
struct EpiGU {
    static constexpr bool PERM = true, AFTER_DRAIN = false, MID = false;
    const float* ss; bf16_t* ACT;
    __device__ __forceinline__ void operator()(const f32x4 (&acc)[2][2][4][2], const Unit& u, int wr, int wc, int fr, int fq) const {
#pragma unroll
        for (int ai = 0; ai < 2; ++ai)
#pragma unroll
            for (int m = 0; m < 4; ++m) {
                const int row = u.pm * BM + ai * HALF + wr * 64 + m * 16 + fr;
                const float rs = row_rs(ss, row);
                float a[8];
#pragma unroll
                for (int n = 0; n < 2; ++n)
#pragma unroll
                    for (int j = 0; j < 4; ++j) { const float gt = rs * acc[ai][0][m][n][j], up = rs * acc[ai][1][m][n][j]; a[4 * n + j] = gt * sigmoidf_(gt) * up; }
                u32x4 w; w.x = cvt_pk_bf16(a[0], a[1]); w.y = cvt_pk_bf16(a[2], a[3]); w.z = cvt_pk_bf16(a[4], a[5]); w.w = cvt_pk_bf16(a[6], a[7]);
                *(u32x4*)(ACT + (size_t)row * DFF + u.pn * HALF + wc * 32 + fq * 8) = w;
            }
    }
};
struct EpiPle {
    static constexpr bool PERM = false, AFTER_DRAIN = false, MID = false;
    const float* ss2; bf16_t* PP; const bf16_t* HB; bf16_t* H3; float* ss3; int pass;
    __device__ __forceinline__ void operator()(const f32x4 (&acc)[2][2][4][2], const Unit& u, int wr, int wc, int fr, int fq) const {
#pragma unroll
        for (int ai = 0; ai < 2; ++ai)
#pragma unroll
            for (int m = 0; m < 4; ++m) {
                const int row = u.pm * BM + ai * HALF + wr * 64 + m * 16 + fr;
                if (pass == 0) {
#pragma unroll
                    for (int bj = 0; bj < 2; ++bj)
#pragma unroll
                        for (int n = 0; n < 2; ++n) { const f32x4 a = acc[ai][bj][m][n]; u32x2 w; w.x = cvt_pk_bf16(a[0], a[1]); w.y = cvt_pk_bf16(a[2], a[3]);
                            *(u32x2*)(PP + (size_t)row * DM + u.pn * BM + bj * HALF + wc * 32 + n * 16 + fq * 4) = w; }
                } else {
                    const float rs = row_rs(ss2, row);
                    float s = 0.f;
#pragma unroll
                    for (int bj = 0; bj < 2; ++bj)
#pragma unroll
                        for (int n = 0; n < 2; ++n) {
                            const size_t off = (size_t)row * DM + u.pn * BM + bj * HALF + wc * 32 + n * 16 + fq * 4;
                            const u32x2 pp = *(const u32x2*)(PP + off), hb = *(const u32x2*)(HB + off); const f32x4 a = acc[ai][bj][m][n];
                            f32x4 h;
                            h[0] = bflo(hb.x) + sigmoidf_(rs * a[0]) * bflo(pp.x); h[1] = bfhi(hb.x) + sigmoidf_(rs * a[1]) * bfhi(pp.x);
                            h[2] = bflo(hb.y) + sigmoidf_(rs * a[2]) * bflo(pp.y); h[3] = bfhi(hb.y) + sigmoidf_(rs * a[3]) * bfhi(pp.y);
                            u32x2 w; w.x = cvt_pk_bf16(h[0], h[1]); w.y = cvt_pk_bf16(h[2], h[3]);
                            *(u32x2*)(H3 + off) = w;
                            s += (h[0] * h[0] + h[1] * h[1]) + (h[2] * h[2] + h[3] * h[3]);
                        }
                    s = sum_x32(sum_x16(s));
                    if (fq == 0) ss3[(size_t)row * 16 + u.pn * 4 + wc] = s;
                }
                asm volatile("" ::: "memory");
            }
    }
};
template <class Epi, class Sched, bool ALIGN_EPI = false, bool SP2 = false>
__device__ __forceinline__ void gemm_phase(PG8_LAS unsigned char* lds, const Gemm g, const Sched& S, const Epi& E) {
    const int tid = tid_fresh(), wid = __builtin_amdgcn_readfirstlane(tid >> 6), lane = tid & 63, wr = wid >> 2, wc = wid & 3, fr = lane & 15, fq = lane >> 4;
    const int K = g.K, nt = K / BK;
    unsigned voffA[2], voffB[2];
#pragma unroll
    for (int i = 0; i < 2; ++i) { int R, C; stage_rc(tid * 16 + i * 8192, R, C); const int Rb = Epi::PERM ? ((R & ~31) + perm32(R & 31)) : R;
        voffA[i] = (unsigned)(R * g.lda + C) * 2u; voffB[i] = (unsigned)(Rb * g.ldb + C) * 2u; }
    const size_t kstep = (size_t)(BK * 2);
    const size_t hstepA = (size_t)HALF * g.lda * 2, hstepB = (size_t)HALF * g.ldb * 2;
    const size_t tstepA = 2 * hstepA, tstepB = 2 * hstepB;
    const unsigned ldsw = (unsigned)wid * 1024u;
    const int aoff = lds_byte(wr * 64 + fr, fq * 8), boff = lds_byte(wc * 32 + fr, fq * 8);
#define PG8_SA(b, h) (((b) * 2 + (h)) * HTB)
#define PG8_SB(b, h) ((4 + (b) * 2 + (h)) * HTB)
#define PG8_STAGE(bufoff, gbase, voff) do { _Pragma("unroll") for (int _i = 0; _i < 2; ++_i) \
        __builtin_amdgcn_global_load_lds((const unsigned*)((const char*)(gbase) + (voff)[_i]), (PG8_LAS unsigned*)(lds + (bufoff) + ldsw + _i * 8192), 16, 0, 0); } while (0)
#define PG8_LDA(dst, b, h) do { _Pragma("unroll") for (int m = 0; m < 4; ++m) _Pragma("unroll") for (int k = 0; k < 2; ++k) dst[m][k] = *(const PG8_LAS bf16x8*)(lds + PG8_SA(b, h) + aoff + m * 2048 + k * 1024); } while (0)
#define PG8_LDB(dst, b, h) do { _Pragma("unroll") for (int n = 0; n < 2; ++n) _Pragma("unroll") for (int k = 0; k < 2; ++k) dst[n][k] = *(const PG8_LAS bf16x8*)(lds + PG8_SB(b, h) + boff + n * 2048 + k * 1024); } while (0)
#define PG8_MMA(ai, bj, At, Bt) do { __builtin_amdgcn_s_setprio(1); _Pragma("unroll") for (int m = 0; m < 4; ++m) _Pragma("unroll") for (int n = 0; n < 2; ++n) _Pragma("unroll") for (int k = 0; k < 2; ++k) \
        acc[ai][bj][m][n] = __builtin_amdgcn_mfma_f32_16x16x32_bf16(Bt[n][k], At[m][k], acc[ai][bj][m][n], 0, 0, 0); __builtin_amdgcn_s_setprio(0); } while (0)
#define PG8_WAIT_V(n) asm volatile("s_waitcnt vmcnt(" #n ")" ::: "memory")
#define PG8_WAIT_L(n) asm volatile("s_waitcnt lgkmcnt(" #n ")" ::: "memory")
#define PG8_BAR __builtin_amdgcn_s_barrier()
#define PG8_SCHED __builtin_amdgcn_sched_barrier(0)
    Unit cur, nxt; int ui = 0;
    if (!S.next(0, cur)) return;
    f32x4 acc[2][2][4][2];
#pragma unroll
    for (int a = 0; a < 2; ++a)
#pragma unroll
        for (int b = 0; b < 2; ++b)
#pragma unroll
            for (int m = 0; m < 4; ++m)
#pragma unroll
                for (int n = 0; n < 2; ++n) acc[a][b][m][n] = (f32x4){0.f, 0.f, 0.f, 0.f};
    bf16x8 At[4][2], B0[2][2], B1[2][2];
    const char* cA = (const char*)g.A + (size_t)cur.pm * tstepA; const char* cB = (const char*)g.Bt + (size_t)cur.pn * tstepB;
    S.a_ready(cur);
    if constexpr (SP2) {
        PG8_STAGE(PG8_SB(0, 0), cB, voffB); PG8_STAGE(PG8_SB(0, 1), cB + hstepB, voffB); PG8_STAGE(PG8_SA(0, 0), cA, voffA); PG8_STAGE(PG8_SA(0, 1), cA + hstepA, voffA);
        if (wr == 1) PG8_BAR;
        PG8_WAIT_V(2); PG8_BAR;
        PG8_STAGE(PG8_SB(1, 0), cB + kstep, voffB); PG8_STAGE(PG8_SA(1, 0), cA + kstep, voffA); PG8_STAGE(PG8_SB(1, 1), cB + hstepB + kstep, voffB);
        PG8_WAIT_V(6); PG8_BAR;
    } else {
        PG8_STAGE(PG8_SB(0, 0), cB, voffB); PG8_STAGE(PG8_SA(0, 0), cA, voffA); PG8_STAGE(PG8_SB(0, 1), cB + hstepB, voffB); PG8_STAGE(PG8_SA(0, 1), cA + hstepA, voffA);
        if (wr == 1) PG8_BAR;
        PG8_WAIT_V(4); PG8_BAR;
        PG8_STAGE(PG8_SB(1, 0), cB + kstep, voffB); PG8_STAGE(PG8_SA(1, 0), cA + kstep, voffA); PG8_STAGE(PG8_SB(1, 1), cB + hstepB + kstep, voffB);
        PG8_WAIT_V(6); PG8_BAR;
    }
    for (;;) {
        const bool has_next = S.next(ui + 1, nxt);
        const char* nA = has_next ? (const char*)g.A + (size_t)nxt.pm * tstepA : cA; const char* nB = has_next ? (const char*)g.Bt + (size_t)nxt.pn * tstepB : cB;
        for (int t = 0; t < nt; t += 2) {
            if constexpr (Epi::MID) { if (t == Epi::MID_T) { __builtin_amdgcn_sched_barrier(0); E.mid(acc, cur, wr, wc, fr, fq); __builtin_amdgcn_sched_barrier(0); } }
            const bool last = (t == nt - 2);
            const char* a1 = cA + (size_t)(t + 1) * kstep;
            const char* a2 = last ? nA : cA + (size_t)(t + 2) * kstep; const char* b2 = last ? nB : cB + (size_t)(t + 2) * kstep;
            const char* a3 = a2 + kstep; const char* b3 = b2 + kstep;
            if (last && has_next) S.a_ready(nxt);
            if constexpr (SP2) {
            PG8_LDB(B0, 0, 0); PG8_LDB(B1, 0, 1); PG8_SCHED; PG8_LDA(At, 0, 0); PG8_STAGE(PG8_SA(1, 1), a1 + hstepA, voffA);
            PG8_WAIT_V(8); PG8_WAIT_L(0); PG8_BAR; PG8_MMA(0, 0, At, B0); PG8_MMA(0, 1, At, B1); PG8_BAR; PG8_SCHED;
            PG8_LDA(At, 0, 1); PG8_STAGE(PG8_SB(0, 0), b2, voffB); PG8_STAGE(PG8_SB(0, 1), b2 + hstepB, voffB); PG8_STAGE(PG8_SA(0, 0), a2, voffA);
            PG8_WAIT_V(8); PG8_WAIT_L(0); PG8_BAR; PG8_MMA(1, 0, At, B0); PG8_MMA(1, 1, At, B1); PG8_BAR; PG8_SCHED;
            PG8_LDB(B0, 1, 0); PG8_LDB(B1, 1, 1); PG8_SCHED; PG8_LDA(At, 1, 0); PG8_STAGE(PG8_SA(0, 1), a2 + hstepA, voffA);
            PG8_WAIT_V(8); PG8_WAIT_L(0); PG8_BAR; PG8_MMA(0, 0, At, B0); PG8_MMA(0, 1, At, B1); PG8_BAR; PG8_SCHED;
            PG8_LDA(At, 1, 1); PG8_STAGE(PG8_SB(1, 0), b3, voffB); PG8_STAGE(PG8_SB(1, 1), b3 + hstepB, voffB); PG8_STAGE(PG8_SA(1, 0), a3, voffA);
            PG8_WAIT_V(8); PG8_WAIT_L(0); PG8_BAR; PG8_MMA(1, 0, At, B0); PG8_MMA(1, 1, At, B1); PG8_BAR; PG8_SCHED;
            } else {
            PG8_LDB(B0, 0, 0); PG8_SCHED; PG8_LDA(At, 0, 0); PG8_STAGE(PG8_SA(1, 1), a1 + hstepA, voffA);
            PG8_WAIT_L(8); PG8_BAR; PG8_WAIT_L(0); PG8_MMA(0, 0, At, B0); PG8_BAR; PG8_SCHED;
            PG8_LDB(B1, 0, 1); PG8_STAGE(PG8_SB(0, 0), b2, voffB);
            PG8_BAR; PG8_WAIT_L(0); PG8_MMA(0, 1, At, B1); PG8_BAR;
            PG8_LDA(At, 0, 1); PG8_STAGE(PG8_SA(0, 0), a2, voffA);
            PG8_BAR; PG8_WAIT_L(0); PG8_MMA(1, 0, At, B0); PG8_BAR; PG8_SCHED;
            PG8_STAGE(PG8_SB(0, 1), b2 + hstepB, voffB);
            PG8_WAIT_V(6); PG8_BAR; PG8_MMA(1, 1, At, B1); PG8_BAR;
            PG8_LDB(B0, 1, 0); PG8_SCHED; PG8_LDA(At, 1, 0); PG8_STAGE(PG8_SA(0, 1), a2 + hstepA, voffA);
            PG8_WAIT_L(8); PG8_BAR; PG8_WAIT_L(0); PG8_MMA(0, 0, At, B0); PG8_BAR; PG8_SCHED;
            PG8_LDB(B1, 1, 1); PG8_STAGE(PG8_SB(1, 0), b3, voffB);
            PG8_BAR; PG8_WAIT_L(0); PG8_MMA(0, 1, At, B1); PG8_BAR;
            PG8_LDA(At, 1, 1); PG8_STAGE(PG8_SA(1, 0), a3, voffA);
            PG8_BAR; PG8_WAIT_L(0); PG8_MMA(1, 0, At, B0); PG8_BAR; PG8_SCHED;
            PG8_STAGE(PG8_SB(1, 1), b3 + hstepB, voffB);
            PG8_WAIT_V(6); PG8_BAR; PG8_MMA(1, 1, At, B1); PG8_BAR;
            }
        }
        if constexpr (ALIGN_EPI) { if (wr == 0) PG8_BAR; }
        if constexpr (!Epi::AFTER_DRAIN) { E(acc, cur, wr, wc, fr, fq); S.done(cur); }
        if (!has_next) break;
#pragma unroll
        for (int a = 0; a < 2; ++a)
#pragma unroll
            for (int b = 0; b < 2; ++b)
#pragma unroll
                for (int m = 0; m < 4; ++m)
#pragma unroll
                    for (int n = 0; n < 2; ++n) acc[a][b][m][n] = (f32x4){0.f, 0.f, 0.f, 0.f};
        cur = nxt; cA = nA; cB = nB; ++ui;
        if constexpr (ALIGN_EPI) { if (wr == 1) PG8_BAR; }
    }
    PG8_WAIT_V(0);
    if constexpr (!ALIGN_EPI) { if (wr == 0) PG8_BAR; }
    PG8_BAR;
    if constexpr (Epi::AFTER_DRAIN) { E.fused(acc, cur, wr, wc, fr, fq, lds, wid, lane); S.done(cur); }
#undef PG8_SA
#undef PG8_SB
#undef PG8_STAGE
#undef PG8_LDA
#undef PG8_LDB
#undef PG8_MMA
#undef PG8_WAIT_V
#undef PG8_WAIT_L
#undef PG8_BAR
#undef PG8_SCHED
}
}

__device__ __forceinline__ void transpose_item(const float* __restrict__ W, int ldw, int k0, int n0src, bf16* __restrict__ WT, int ldt, int drow0, const float* __restrict__ gain, LAS float* scr, int lane, int kdst = 0) {
#pragma unroll 8
    for (int i = 0; i < 32; ++i) { const int kk = 2 * i + (lane >> 5); float v = W[(size_t)(k0 + kk) * ldw + n0src + (lane & 31)]; if (gain) v *= gain[k0 + kk]; scr[kk * 33 + (lane & 31)] = v; }
    asm volatile("s_waitcnt lgkmcnt(0)" ::: "memory");
    const int c = lane & 7;
#pragma unroll
    for (int j = 0; j < 4; ++j) { const int n = (lane >> 3) + 8 * j; const LAS float* s = scr + (8 * c) * 33 + n;
        u32x4v o; o.x = pk2(s[0 * 33], s[1 * 33]); o.y = pk2(s[2 * 33], s[3 * 33]); o.z = pk2(s[4 * 33], s[5 * 33]); o.w = pk2(s[6 * 33], s[7 * 33]);
        *(u32x4v*)(WT + (size_t)(drow0 + n) * ldt + kdst + k0 + 8 * c) = o; }
    asm volatile("s_waitcnt lgkmcnt(0)" ::: "memory");
}

__device__ __forceinline__ void convert_weights(const Params& P, LAS unsigned char* lds, int gw, int NGW, int it0, int it1) {
    const int tid = tid_fresh(), lane = tid & 63, wave = tid >> 6;
    unsigned char* ws = P.ws;
    LAS float* scr = (LAS float*)(lds + wave * 8448);
    constexpr int I_IN = 16 * 264, I_A = 4 * 32, I_B = 16 * 32, I_O = 16 * 32, I_G = 16 * 88, I_U = 16 * 88, I_D = 44 * 32, I_PG = 16 * 32, I_PP = 4 * 32;
    for (int it = it0 + gw; it < it1; it += NGW) {
        int r = it;
        if (r < I_IN) { const int kb = r / 264, nb = r % 264, n0 = nb * 32; transpose_item(P.in[12], 8456, kb * 64, n0 + (n0 >= 6400 ? 8 : 0), (bf16*)(ws + WS_WIN), DM, n0, P.in[11], scr, lane); continue; } r -= I_IN;
        if (r < I_A) { const int kb = r / 32, nb = r % 32; transpose_item(P.in[18], DM, kb * 64, nb * 32, (bf16*)(ws + WS_WA), KMIX, nb * 32, nullptr, scr, lane, 0); continue; } r -= I_A;
        if (r < I_B) { const int kb = r / 32, nb = r % 32; transpose_item(P.in[19], DM, kb * 64, nb * 32, (bf16*)(ws + WS_WA), KMIX, nb * 32, nullptr, scr, lane, 256); continue; } r -= I_B;
        if (r < I_O) { const int kb = r / 32, nb = r % 32; transpose_item(P.in[20], DM, kb * 64, nb * 32, (bf16*)(ws + WS_WO), DM, nb * 32, nullptr, scr, lane); continue; } r -= I_O;
        if (r < I_G) { const int kb = r / 88, nb = r % 88, n0 = nb * 32; transpose_item(P.in[22], DFF, kb * 64, n0, (bf16*)(ws + WS_WGU), DM, 256 * (n0 >> 7) + (n0 & 127), P.in[21], scr, lane); continue; } r -= I_G;
        if (r < I_U) { const int kb = r / 88, nb = r % 88, n0 = nb * 32; transpose_item(P.in[23], DFF, kb * 64, n0, (bf16*)(ws + WS_WGU), DM, 256 * (n0 >> 7) + 128 + (n0 & 127), P.in[21], scr, lane); continue; } r -= I_U;
        if (r < I_D) { const int kb = r / 32, nb = r % 32; transpose_item(P.in[24], DM, kb * 64, nb * 32, (bf16*)(ws + WS_WD), DFF, nb * 32, nullptr, scr, lane); continue; } r -= I_D;
        if (r < I_PG) { const int kb = r / 32, nb = r % 32; transpose_item(P.in[26], DM, kb * 64, nb * 32, (bf16*)(ws + WS_WPG), DM, nb * 32, P.in[25], scr, lane); continue; } r -= I_PG;
        { const int kb = r / 32, nb = r % 32; transpose_item(P.in[27], DM, kb * 64, nb * 32, (bf16*)(ws + WS_WPP), 256, nb * 32, nullptr, scr, lane); }
    }
}
constexpr int W_ITEMS_ALL = 16 * 264 + 4 * 32 + 16 * 32 + 16 * 32 + 16 * 88 + 16 * 88 + 44 * 32 + 16 * 32 + 4 * 32;

__device__ __forceinline__ void phase0(const Params& P, LAS unsigned char* lds, int G) {
    const int tid = tid_fresh(), lane = tid & 63, wave = tid >> 6;
    const int gw = blockIdx.x * 8 + wave, NGW = G * 8;
    unsigned char* ws = P.ws;
    const float* w_in = P.in[12];
    const float* norm_mix = P.in[11];
    LAS float* wg = (LAS float*)(lds + 72 * 1024);
    for (int idx = tid; idx < 8192; idx += 512) { const int j = idx >> 10, k = idx & 1023; wg[idx] = w_in[(size_t)k * 8456 + 6400 + j] * norm_mix[k]; }
    __syncthreads();
    {
        const float* xp = P.in[0]; const float* xs = P.in[1];
        bf16* XN = (bf16*)(ws + WS_XN); float* GT = (float*)(ws + WS_GATES);
        const float* b_ig = P.in[15]; const float* b_fg = P.in[16];
        for (int row = gw; row < MT; row += NGW) {
            const float* xr = row < MP ? xp + (size_t)row * DM : xs + (size_t)(row - MP) * DM;
            f32x4v v[4]; float s = 0.f;
#pragma unroll
            for (int j = 0; j < 4; ++j) { v[j] = *(const f32x4v*)(xr + 256 * j + 4 * lane); s += (v[j][0] * v[j][0] + v[j][1] * v[j][1]) + (v[j][2] * v[j][2] + v[j][3] * v[j][3]); }
            const float rs = 1.0f / sqrtf(wave_sum(s) * (1.0f / DM) + EPSN);
#pragma unroll
            for (int j = 0; j < 4; ++j) { v[j] = v[j] * rs; u32x2v w; w.x = pk2(v[j][0], v[j][1]); w.y = pk2(v[j][2], v[j][3]); *(u32x2v*)(XN + (size_t)row * DM + 256 * j + 4 * lane) = w; }
            float d[8];
#pragma unroll
            for (int gi = 0; gi < 8; ++gi) {
                float s_ = 0.f;
#pragma unroll
                for (int j = 0; j < 4; ++j) { const f32x4v w = *(const LAS f32x4v*)(wg + gi * 1024 + 256 * j + 4 * lane); s_ += (v[j][0] * w[0] + v[j][1] * w[1]) + (v[j][2] * w[2] + v[j][3] * w[3]); }
                d[gi] = s_;
            }
            { const bool b0 = lane & 1, b1 = lane & 2, b2 = lane & 4;
#pragma unroll
              for (int i = 0; i < 4; ++i) { const float snd = b0 ? d[i] : d[i + 4], kp = b0 ? d[i + 4] : d[i]; d[i] = kp + __shfl_xor(snd, 1); }
#pragma unroll
              for (int i = 0; i < 2; ++i) { const float snd = b1 ? d[i] : d[i + 2], kp = b1 ? d[i + 2] : d[i]; d[i] = kp + __shfl_xor(snd, 2); }
              { const float snd = b2 ? d[0] : d[1], kp = b2 ? d[1] : d[0]; d[0] = kp + __shfl_xor(snd, 4); }
              d[0] += __shfl_xor(d[0], 8); d[0] += __shfl_xor(d[0], 16); d[0] += __shfl_xor(d[0], 32); }
            if (lane < 8) {
                const int gidx = 4 * (lane & 1) + 2 * ((lane >> 1) & 1) + ((lane >> 2) & 1);
                const float mine = d[0];
                if (gidx < 4) GT[(size_t)row * 8 + gidx] = mine + b_ig[gidx];
                else { const float x = mine + b_fg[gidx - 4]; const float e = exp_(-fabsf(x));
                    const float l1p = e < 0.02f ? e * (1.0f - e * (0.5f - e * (0.33333333f - 0.25f * e))) : __logf(1.0f + e);
                    GT[(size_t)row * 8 + gidx] = fminf(x, 0.f) - l1p; }
            }
        }
    }
    if (blockIdx.x == 0) { for (int i = tid; i < MS * 16; i += 512) { ((float*)(ws + WS_SS1))[(size_t)MP * 16 + i] = 0.f; ((float*)(ws + WS_SS2))[(size_t)MP * 16 + i] = 0.f; ((float*)(ws + WS_SS3))[(size_t)MP * 16 + i] = 0.f; } }
    {
        const float* pp = P.in[9]; const float* ps = P.in[10]; bf16* PB = (bf16*)(ws + WS_PB);
        for (int idx = blockIdx.x * 512 + tid; idx < MT * 32; idx += G * 512) {
            const int row = idx >> 5, c = (idx & 31) * 8;
            const float* src = row < MP ? pp + (size_t)row * 256 + c : ps + (size_t)(row - MP) * 256 + c;
            const f32x4v a = *(const f32x4v*)src, b = *(const f32x4v*)(src + 4);
            u32x4v o; o.x = pk2(a[0], a[1]); o.y = pk2(a[2], a[3]); o.z = pk2(b[0], b[1]); o.w = pk2(b[2], b[3]);
            *(u32x4v*)(PB + (size_t)row * 256 + c) = o;
        }
    }
    {
        float* RT = (float*)(ws + WS_ROPE);
        for (int idx = blockIdx.x * 512 + tid; idx < 4097 * 8; idx += G * 512) {
            const int pi = idx >> 3, i = idx & 7;
            const float inv = i == 0 ? 1.0f : i == 1 ? 0.193922743f : i == 2 ? 0.0376060307f : i == 3 ? 0.00729266461f : i == 4 ? 0.00141421356f : i == 5 ? 0.000274248188f : i == 6 ? 5.31829573e-05f : 1.03133852e-05f;
            const float ang = (float)(pi < 4096 ? pi : 16384) * inv;
            double rev = (double)ang * 0.15915494309189535; rev -= floor(rev);
            const float rf = (float)rev;
            RT[2 * idx] = __builtin_amdgcn_cosf(rf); RT[2 * idx + 1] = __builtin_amdgcn_sinf(rf);
        }
    }
    convert_weights(P, lds, gw, NGW, 0, 16 * 264);
}

typedef float f32x16v __attribute__((ext_vector_type(16)));
__device__ __forceinline__ int crow(int i, int h) { return (i & 3) + 8 * (i >> 2) + 4 * h; }

__device__ __forceinline__ void attn_task(const bf16* __restrict__ Z, const bf16* __restrict__ VT, bf16* __restrict__ OG, float* __restrict__ LSE, int task, int lane, LAS unsigned char* vl) {
    const int tile = task & 127, bh = task >> 7, hinst = bh % 12, b = bh / 12;
    const int g = hinst >> 2, h = hinst & 3, lg = 2 * g, nsub = 4096 >> lg;
    const int res = tile >> (7 - lg), qt = tile & ((128 >> lg) - 1), q0 = qt * 32;
    const int r32 = lane & 31, hi = lane >> 5;
    const int tq = ((q0 + r32) << lg) + res;
    const size_t rowq = (size_t)b * 4096 + tq;
    const bf16* qp = Z + rowq * NZ + ZQ + hinst * 64 + 8 * hi;
    s16x8v qf[4];
#pragma unroll
    for (int s = 0; s < 4; ++s) qf[s] = *(const s16x8v*)(qp + 16 * s);
    s16x8v kf[5][4];
#pragma unroll
    for (int kt = 0; kt < 5; ++kt) {
        const int kb = q0 - 128 + 32 * kt;
        const int tk = (((kb >= 0 ? kb : 0) + r32) << lg) + res;
        const bf16* kp = Z + ((size_t)b * 4096 + tk) * NZ + ZK + hinst * 64 + 8 * hi;
#pragma unroll
        for (int s = 0; s < 4; ++s) kf[kt][s] = *(const s16x8v*)(kp + 16 * s);
    }
    f32x16v sc[5];
    const float NEGINF = -__builtin_inff();
#pragma unroll
    for (int kt = 0; kt < 5; ++kt) {
        const int kb = q0 - 128 + 32 * kt;
        f32x16v a;
#pragma unroll
        for (int i = 0; i < 16; ++i) a[i] = 0.f;
#pragma unroll
        for (int s = 0; s < 4; ++s) a = __builtin_amdgcn_mfma_f32_32x32x16_bf16(kf[kt][s], qf[s], a, 0, 0, 0);
        if (kt == 0) {
#pragma unroll
            for (int i = 0; i < 16; ++i) if (crow(i, hi) < r32) a[i] = NEGINF;
        }
        if (kt == 4) {
#pragma unroll
            for (int i = 0; i < 16; ++i) if (crow(i, hi) > r32) a[i] = NEGINF;
        }
        if (kb < 0) {
#pragma unroll
            for (int i = 0; i < 16; ++i) a[i] = NEGINF;
        }
        sc[kt] = a;
    }
    const int vkey = lane >> 3, vpc = lane & 7;
    u32x4v vr[5][4];
#pragma unroll
    for (int kt = 0; kt < 5; ++kt) {
        const int kb = q0 - 128 + 32 * kt, kbc = kb >= 0 ? kb : 0;
#pragma unroll
        for (int i = 0; i < 4; ++i) { const int tv = ((kbc + vkey + 8 * i) << lg) + res; vr[kt][i] = *(const u32x4v*)(Z + ((size_t)b * 4096 + tv) * NZ + ZV + hinst * 64 + vpc * 8); }
    }
    float m = NEGINF;
#pragma unroll
    for (int kt = 0; kt < 5; ++kt)
#pragma unroll
        for (int i = 0; i < 16; ++i) m = fmaxf(m, sc[kt][i]);
    m = max_x32(m);
    float l = 0.f;
#pragma unroll
    for (int kt = 0; kt < 5; ++kt)
#pragma unroll
        for (int i = 0; i < 16; ++i) { const float p = __builtin_amdgcn_exp2f(sc[kt][i] - m); sc[kt][i] = p; l += p; }
    l = sum_x32(l);
    f32x16v o0, o1;
#pragma unroll
    for (int i = 0; i < 16; ++i) { o0[i] = 0.f; o1[i] = 0.f; }
    {
        const int q4 = (lane & 15) >> 2, p4 = lane & 3, dh = (lane >> 4) & 1;
        const int troff = (4 * hi + q4) * 144 + dh * 32 + 8 * p4;
#pragma unroll
        for (int kt = 0; kt < 5; ++kt) {
#pragma unroll
            for (int i = 0; i < 4; ++i) *(LAS u32x4v*)(vl + (vkey + 8 * i) * 144 + vpc * 16) = vr[kt][i];
            asm volatile("s_waitcnt lgkmcnt(0)" ::: "memory");
            typedef short v4s_t __attribute__((ext_vector_type(4)));
            v4s_t tl[2][2], th[2][2];
#pragma unroll
            for (int s2 = 0; s2 < 2; ++s2)
#pragma unroll
                for (int dt = 0; dt < 2; ++dt) {
                    tl[s2][dt] = __builtin_amdgcn_ds_read_tr16_b64_v4i16((LAS v4s_t*)(vl + troff + (16 * s2) * 144 + dt * 64));
                    th[s2][dt] = __builtin_amdgcn_ds_read_tr16_b64_v4i16((LAS v4s_t*)(vl + troff + (16 * s2 + 8) * 144 + dt * 64));
                }
#pragma unroll
            for (int s2 = 0; s2 < 2; ++s2) {
                u32x4v pw;
                pw.x = pk2(sc[kt][8 * s2 + 0], sc[kt][8 * s2 + 1]); pw.y = pk2(sc[kt][8 * s2 + 2], sc[kt][8 * s2 + 3]);
                pw.z = pk2(sc[kt][8 * s2 + 4], sc[kt][8 * s2 + 5]); pw.w = pk2(sc[kt][8 * s2 + 6], sc[kt][8 * s2 + 7]);
                const s16x8v pf = __builtin_bit_cast(s16x8v, pw);
                const s16x8v fa = __builtin_shufflevector(tl[s2][0], th[s2][0], 0, 1, 2, 3, 4, 5, 6, 7), fb = __builtin_shufflevector(tl[s2][1], th[s2][1], 0, 1, 2, 3, 4, 5, 6, 7);
                o0 = __builtin_amdgcn_mfma_f32_32x32x16_bf16(fa, pf, o0, 0, 0, 0);
                o1 = __builtin_amdgcn_mfma_f32_32x32x16_bf16(fb, pf, o1, 0, 0, 0);
            }
            asm volatile("s_waitcnt lgkmcnt(0)" ::: "memory");
        }
    }
    const float inv = 1.0f / l;
    bf16* op = OG + ((size_t)g * MPAD + rowq) * 256 + h * 64 + 16 * hi;
#pragma unroll
    for (int hq = 0; hq < 2; ++hq) {
        u32x4v w0, w1;
        w0.x = pk2(o0[8 * hq] * inv, o0[8 * hq + 1] * inv); w0.y = pk2(o0[8 * hq + 2] * inv, o0[8 * hq + 3] * inv); w0.z = pk2(o0[8 * hq + 4] * inv, o0[8 * hq + 5] * inv); w0.w = pk2(o0[8 * hq + 6] * inv, o0[8 * hq + 7] * inv);
        w1.x = pk2(o1[8 * hq] * inv, o1[8 * hq + 1] * inv); w1.y = pk2(o1[8 * hq + 2] * inv, o1[8 * hq + 3] * inv); w1.z = pk2(o1[8 * hq + 4] * inv, o1[8 * hq + 5] * inv); w1.w = pk2(o1[8 * hq + 6] * inv, o1[8 * hq + 7] * inv);
        *(u32x4v*)(op + 8 * hq) = w0; *(u32x4v*)(op + 32 + 8 * hq) = w1;
    }
    if (hi == 0) LSE[((size_t)g * MPAD + rowq) * 4 + h] = (m + __log2f(l)) * LN2;
}

__device__ __forceinline__ void sample_attn_task(const Params& P, const bf16* __restrict__ Z, bf16* __restrict__ OG, float* __restrict__ LSE, int task, int lane, LAS float* pS) {
    const int hinst = task % 12, b = task / 12, g = hinst >> 2, h = hinst & 3, lg = 2 * g, W = 128 << lg;
    const float* cache = P.in[2 + g];
    const size_t row = (size_t)MP + b;
    float q[64];
    {
        const bf16* qp = Z + row * NZ + ZQ + hinst * 64;
#pragma unroll
        for (int c = 0; c < 8; ++c) { const u32x4v w = *(const u32x4v*)(qp + 8 * c);
            q[8 * c] = bflo(w.x); q[8 * c + 1] = bfhi(w.x); q[8 * c + 2] = bflo(w.y); q[8 * c + 3] = bfhi(w.y); q[8 * c + 4] = bflo(w.z); q[8 * c + 5] = bfhi(w.z); q[8 * c + 6] = bflo(w.w); q[8 * c + 7] = bfhi(w.w); }
    }
    float s[3];
#pragma unroll
    for (int rr = 0; rr < 3; ++rr) {
        const int i = lane + 64 * rr;
        float d = -__builtin_inff();
        if (i <= 128 && (rr < 2 || lane == 0)) {
            d = 0.f;
            if (i == 0) {
                const bf16* kp = Z + row * NZ + ZK + hinst * 64;
#pragma unroll
                for (int c = 0; c < 8; ++c) { const u32x4v w = *(const u32x4v*)(kp + 8 * c);
                    d += q[8 * c] * bflo(w.x) + q[8 * c + 1] * bfhi(w.x) + q[8 * c + 2] * bflo(w.y) + q[8 * c + 3] * bfhi(w.y) + q[8 * c + 4] * bflo(w.z) + q[8 * c + 5] * bfhi(w.z) + q[8 * c + 6] * bflo(w.w) + q[8 * c + 7] * bfhi(w.w); }
            } else {
                const float* kp = cache + (((size_t)b * W + (W - (i << lg))) * 2 + 0) * 256 + h * 64;
#pragma unroll
                for (int c = 0; c < 16; ++c) { const f32x4v w = *(const f32x4v*)(kp + 4 * c); d += q[4 * c] * w[0] + q[4 * c + 1] * w[1] + q[4 * c + 2] * w[2] + q[4 * c + 3] * w[3]; }
            }
        }
        s[rr] = d;
    }
    const float m = wave_max(fmaxf(fmaxf(s[0], s[1]), s[2]));
    float l = 0.f;
#pragma unroll
    for (int rr = 0; rr < 3; ++rr) { const float p = __builtin_amdgcn_exp2f(s[rr] - m); l += p; const int i = lane + 64 * rr; if (i <= 128 && (rr < 2 || lane == 0)) pS[i] = p; }
    l = wave_sum(l);
    asm volatile("s_waitcnt lgkmcnt(0)" ::: "memory");
    float o = pS[0] * bf2f(Z[row * NZ + ZV + hinst * 64 + lane]);
    for (int i0 = 1; i0 <= 128; i0 += 16) {
        float vv[16];
#pragma unroll
        for (int u = 0; u < 16; ++u) vv[u] = cache[(((size_t)b * W + (W - ((i0 + u) << lg))) * 2 + 1) * 256 + h * 64 + lane];
#pragma unroll
        for (int u = 0; u < 16; ++u) o += pS[i0 + u] * vv[u];
    }
    OG[((size_t)g * MPAD + row) * 256 + h * 64 + ((lane & 32) | ((lane & 4) << 2) | ((lane & 24) >> 1) | (lane & 3))] = (bf16)f2bf(o / l);
    if (lane == 0) LSE[((size_t)g * MPAD + row) * 4 + h] = (m + __log2f(l)) * LN2;
    asm volatile("s_waitcnt lgkmcnt(0)" ::: "memory");
}

__device__ __forceinline__ void attention_work(const Params& P, LAS unsigned char* lds, int wv, int nwv) {
    const int tid = tid_fresh(), lane = tid & 63, wave = tid >> 6;
    unsigned char* ws = P.ws;
    const bf16* Z = (const bf16*)(ws + WS_Z); const bf16* VT = (const bf16*)(ws + WS_VT);
    bf16* OG = (bf16*)(ws + WS_OG); float* LSE = (float*)(ws + WS_LSE);
    for (int rp_ = 0, nrp_ = opaque_s(REP_SA); rp_ < nrp_; ++rp_)
    for (int task = wv; task < 32 * 12; task += nwv) sample_attn_task(P, Z, OG, LSE, task, lane, (LAS float*)(lds + wave * 1024));
    for (int rp_ = 0, nrp_ = opaque_s(REP_AT); rp_ < nrp_; ++rp_)
    for (int task = wv; task < 4 * 12 * 128; task += nwv) attn_task(Z, VT, OG, LSE, task, lane, lds + 16384 + wave * 4608);
}

__device__ __forceinline__ void gate_scan_task(const float* __restrict__ GT, f32x4v* __restrict__ GS, int task, int lane);
__device__ __forceinline__ void phase2a(const Params& P, LAS unsigned char* lds, int G) {
    const int tid = tid_fresh(), lane = tid & 63, wave = tid >> 6;
    const int gw = blockIdx.x * 8 + wave, NGW = G * 8;
    unsigned char* ws = P.ws;
    const bf16* Z = (const bf16*)(ws + WS_Z);
    for (int task = gw; task < 1024; task += NGW) gate_scan_task((const float*)(ws + WS_GATES), (f32x4v*)(ws + WS_GS), task, lane);
    {
        bf16* QK = (bf16*)(ws + WS_QK); const float* cw = P.in[13]; const float* cb = P.in[14];
        for (int rp_ = 0, nrp_ = opaque_s(REP_CV); rp_ < nrp_; ++rp_)
        for (int idx = blockIdx.x * 512 + tid; idx < (MP / 4) * 256; idx += G * 512) {
            const int row0 = (idx >> 8) * 4, c = (idx & 255) * 8, t0 = row0 & 4095;
            u32x4v zr[7];
#pragma unroll
            for (int j = 0; j < 7; ++j) { if (t0 + j - 3 >= 0) zr[j] = *(const u32x4v*)(Z + (size_t)(row0 + j - 3) * NZ + ZMQ + c); else zr[j] = (u32x4v){0u, 0u, 0u, 0u}; }
            f32x4v w[4][2];
#pragma unroll
            for (int j = 0; j < 4; ++j) { w[j][0] = *(const f32x4v*)(cw + j * 2048 + c); w[j][1] = *(const f32x4v*)(cw + j * 2048 + c + 4); }
            const f32x4v b0 = *(const f32x4v*)(cb + c), b1 = *(const f32x4v*)(cb + c + 4);
            const float sc = c >= 1024 ? 0.0625f : 1.0f;
#pragma unroll
            for (int r = 0; r < 4; ++r) {
                float y[8] = {b0[0], b0[1], b0[2], b0[3], b1[0], b1[1], b1[2], b1[3]};
#pragma unroll
                for (int j = 0; j < 4; ++j) { const u32x4v z = zr[r + j];
                    y[0] += w[j][0][0] * bflo(z.x); y[1] += w[j][0][1] * bfhi(z.x); y[2] += w[j][0][2] * bflo(z.y); y[3] += w[j][0][3] * bfhi(z.y);
                    y[4] += w[j][1][0] * bflo(z.z); y[5] += w[j][1][1] * bfhi(z.z); y[6] += w[j][1][2] * bflo(z.w); y[7] += w[j][1][3] * bfhi(z.w); }
#pragma unroll
                for (int j = 0; j < 8; ++j) y[j] = y[j] * sigmoidf_(y[j]) * sc;
                u32x4v o; o.x = pk2(y[0], y[1]); o.y = pk2(y[2], y[3]); o.z = pk2(y[4], y[5]); o.w = pk2(y[6], y[7]);
                *(u32x4v*)(QK + (size_t)(row0 + r) * 2048 + c) = o;
            }
        }
    }
    {
        const float* sc = P.in[5]; float* out = P.out + O_CONV_S;
        for (int idx = blockIdx.x * 512 + tid; idx < 32 * 2 * 2048; idx += G * 512) { const int b = idx / 4096, r = (idx >> 11) & 1, c = idx & 2047; out[(size_t)(b * 3 + r) * 2048 + c] = sc[(size_t)(b * 3 + r + 1) * 2048 + c]; }
    }
}
#define XB_TMO      128
#define XB_XCNT(j)  (256  + 64 * (j))
#define XB_XSUB(j)  (1280 + 64 * (j))
#define XB_XGEN(j)  (2304 + 64 * (j))
#define XB_TOP      3328
#define XB_TOPGEN   3392
#define XCD_BAR_WORDS 3456
#define XB_SPIN_CAP (1u << 18)

__device__ __forceinline__ unsigned xb_ld(unsigned* p)              { return __hip_atomic_load(p, __ATOMIC_RELAXED, __HIP_MEMORY_SCOPE_AGENT); }
__device__ __forceinline__ unsigned xb_add(unsigned* p, unsigned v) { return __hip_atomic_fetch_add(p, v, __ATOMIC_RELAXED, __HIP_MEMORY_SCOPE_AGENT); }
__device__ __forceinline__ unsigned xb_xcc_id() { return (unsigned)__builtin_amdgcn_s_getreg((3 << 11) | 20) & 0xFu; }
#define XB_SPIN(cond, bar) do { unsigned _sp = 0; while (cond) { __builtin_amdgcn_s_sleep(1); \
    if ((++_sp & 255u) == 0u) { if (xb_ld(&(bar)[XB_TMO])) break; if (_sp > XB_SPIN_CAP) { atomicAdd(&(bar)[XB_TMO], 1u); break; } } } } while (0)

struct XcdBarrier {
    unsigned* bar; unsigned x;
    volatile LAS unsigned* st;
};

__device__ __forceinline__ XcdBarrier xcd_barrier_post(unsigned* bar, volatile LAS unsigned* st) {
    XcdBarrier b; b.bar = bar; b.x = xb_xcc_id(); b.st = st;
    if (threadIdx.x == 0) (void)xb_add(&bar[XB_XCNT(b.x)], 1u);
    return b;
}
__device__ __forceinline__ void xcd_barrier_complete(unsigned* bar, unsigned x, unsigned& nloc, unsigned& nx) {
    const unsigned G = gridDim.x * gridDim.y * gridDim.z;
    unsigned sum, cnt, mine, sp = 0u;
    for (;;) {
        sum = 0u; cnt = 0u; mine = 0u;
#pragma unroll
        for (unsigned j = 0; j < 16; ++j) { const unsigned c = xb_ld(&bar[XB_XCNT(j)]); sum += c; cnt += (c > 0u) ? 1u : 0u; mine = (j == x) ? c : mine; }
        if (sum == G) break;
        __builtin_amdgcn_s_sleep(1);
        if ((++sp & 255u) == 0u) { if (xb_ld(&bar[XB_TMO])) break; if (sp > XB_SPIN_CAP) { atomicAdd(&bar[XB_TMO], 1u); break; } }
    }
    nloc = mine > 0u ? mine : 1u; nx = cnt > 0u ? cnt : 1u;
}

__device__ __forceinline__ void xcd_barrier(const XcdBarrier& b) {
    asm volatile("s_waitcnt vmcnt(0)" ::: "memory");
    __syncthreads();
    if (threadIdx.x == 0) {
        unsigned* bar = b.bar;
        __builtin_amdgcn_s_waitcnt(0);
        unsigned nloc = b.st[0], nx = b.st[1];
        if (nloc == 0u) { xcd_barrier_complete(bar, b.x, nloc, nx); b.st[0] = nloc; b.st[1] = nx; }
        const unsigned old = xb_add(&bar[XB_XSUB(b.x)], 1u);
        const unsigned gen = old / nloc;
        if (old + 1u == (gen + 1u) * nloc) {
            __builtin_amdgcn_fence(__ATOMIC_RELEASE, "agent");
            asm volatile("s_waitcnt vmcnt(0)" ::: "memory");
            const unsigned og = xb_add(&bar[XB_TOP], 1u);
            const unsigned tg = og / nx;
            if (og + 1u == (tg + 1u) * nx) xb_add(&bar[XB_TOPGEN], 1u);
            else XB_SPIN(xb_ld(&bar[XB_TOPGEN]) == tg, bar);
            __builtin_amdgcn_fence(__ATOMIC_ACQUIRE, "agent");
            xb_add(&bar[XB_XGEN(b.x)], 1u);
            asm volatile("s_waitcnt vmcnt(0)" ::: "memory");
        } else {
            XB_SPIN(xb_ld(&bar[XB_XGEN(b.x)]) == gen, bar);
            __builtin_amdgcn_fence(__ATOMIC_ACQUIRE, "agent");
            asm volatile("s_waitcnt vmcnt(0)" ::: "memory");
        }
    }
    __syncthreads();
}

typedef short bf16x8m __attribute__((ext_vector_type(8)));
#define MFMA16(a, b, c) __builtin_amdgcn_mfma_f32_16x16x32_bf16((a), (b), (c), 0, 0, 0)

constexpr int ML_QS = 0, ML_KS = 33792, ML_VS = 67584, ML_PS = 72704, ML_CT = 81920, ML_NS = 98816, ML_AS = 99840, ML_MS = 100096, ML_EM = 100352, ML_WK = 100608,
              ML_WI = 100864, ML_QN = 101120, ML_RS = 101376, ML_SC = 102400, ML_MP = 103680, ML_VW = 104448, ML_NPT = 109568;
constexpr int QROW = 528, VROW = 80, PROW = 144;
typedef short v4i16_t __attribute__((ext_vector_type(4)));
__device__ __forceinline__ v4i16_t ldtr(LAS const unsigned char* p) { return __builtin_amdgcn_ds_read_tr16_b64_v4i16((LAS v4i16_t*)p); }

__device__ __forceinline__ void gate_scan_task(const float* __restrict__ GT, f32x4v* __restrict__ GS, int task, int lane) {
    const int ck = task & 63, bh = task >> 6, b = bh >> 2, h = bh & 3;
    const size_t row = (size_t)b * 4096 + ck * 64 + lane;
    const float lf = GT[row * 8 + 4 + h], ig = GT[row * 8 + h];
    float bc = lf;
#pragma unroll
    for (int o = 1; o < 64; o <<= 1) { const float u = __shfl_up(bc, o); if (lane >= o) bc += u; }
    const float a = ig - bc;
    float cm = a;
#pragma unroll
    for (int o = 1; o < 64; o <<= 1) { const float u = __shfl_up(cm, o); if (lane >= o) cm = fmaxf(cm, u); }
    GS[(size_t)bh * 4096 + ck * 64 + lane] = (f32x4v){bc, a, cm, 0.f};
}

__device__ __forceinline__ void mlstm_unit(const Params& P, LAS unsigned char* lds, int unit) {
    const int tid = tid_fresh(), lane = tid & 63, w = tid >> 6, fr = lane & 15, fq = lane >> 4;
    const int b = unit >> 5, h = (unit >> 3) & 3, dvs = unit & 7;
    unsigned char* ws = P.ws;
    const size_t rowbase = (size_t)b * 4096;
    const bf16* Qg = (const bf16*)(ws + WS_QK) + rowbase * 2048 + h * 256;
    const bf16* Kg = Qg + 1024;
    const bf16* Vg = (const bf16*)(ws + WS_Z) + rowbase * NZ + ZMV + h * 256 + dvs * 32;
    const f32x4v* GS = (const f32x4v*)(ws + WS_GS) + (size_t)(b * 4 + h) * 4096;
    bf16* HB = (bf16*)(ws + WS_HBUF) + rowbase * DM + h * 256 + dvs * 32;
    float* SSQ = (float*)(ws + WS_SSQ) + (rowbase * 4 + h) * 16 + dvs * 2;
    LAS float* nS = (LAS float*)(lds + ML_NS); LAS float* aS = (LAS float*)(lds + ML_AS); LAS float* MS_ = (LAS float*)(lds + ML_MS); LAS float* emS = (LAS float*)(lds + ML_EM);
    LAS float* wkS = (LAS float*)(lds + ML_WK); LAS float* wiS = (LAS float*)(lds + ML_WI); LAS float* qnS = (LAS float*)(lds + ML_QN); LAS float* rsS = (LAS float*)(lds + ML_RS);
    LAS float* scS = (LAS float*)(lds + ML_SC); LAS float* mpS = (LAS float*)(lds + ML_MP);
    for (int i = tid; i < 32 * QROW / 4; i += 512) ((LAS unsigned*)(lds + ML_CT))[i] = 0u;
    if (tid < 256) nS[tid] = 0.f;
    if (w == 0) {
        const f32x4v gl = GS[lane * 64 + 63];
        float m = 0.f;
        for (int c = 0; c < 64; ++c) { const float bl = __shfl(gl[0], c), cl = __shfl(gl[2], c); if (lane == c) mpS[c] = m; m = bl + fmaxf(m, cl); }
        if (lane == 0) mpS[64] = m;
    }
    pg8::f32x4 Cacc[2][2];
#pragma unroll
    for (int a = 0; a < 2; ++a)
#pragma unroll
        for (int c = 0; c < 2; ++c) Cacc[a][c] = (pg8::f32x4){0.f, 0.f, 0.f, 0.f};
    const int mt = w >> 1;
#define ML_BAR() do { asm volatile("s_waitcnt lgkmcnt(0)" ::: "memory"); __builtin_amdgcn_s_barrier(); asm volatile("" ::: "memory"); } while (0)
    u32x4v pq[4], pk[4], pv; f32x4v pg; float pgr_a, pgl_cm;
    const int q4 = fr >> 2, p4 = fr & 3;
    const int trv = (8 * fq + q4) * VROW + 8 * p4;
    const int trk = (8 * fq + q4) * QROW + 8 * p4;
#define ML_PREFETCH(CK) do { const int t0_ = (CK) * 64; \
        _Pragma("unroll") for (int i = 0; i < 4; ++i) { const int idx = tid + 512 * i, r = idx >> 5, c = idx & 31; \
            pq[i] = *(const u32x4v*)(Qg + (size_t)(t0_ + r) * 2048 + c * 8); pk[i] = *(const u32x4v*)(Kg + (size_t)(t0_ + r) * 2048 + c * 8); } \
        if (tid < 256) { const int r = tid >> 2, c = tid & 3; pv = *(const u32x4v*)(Vg + (size_t)(t0_ + r) * NZ + c * 8); pgr_a = ((const float*)(GS + t0_ + r))[1]; pgl_cm = ((const float*)(GS + t0_ + 63))[2]; } \
        if (w == 0) pg = GS[t0_ + lane]; } while (0)
#define ML_COMMIT(CK) do { const float mp_ = mpS[(CK)]; \
        _Pragma("unroll") for (int i = 0; i < 4; ++i) { const int idx = tid + 512 * i, r = idx >> 5, c = idx & 31; \
            *(LAS u32x4v*)(lds + ML_QS + r * QROW + c * 16) = pq[i]; *(LAS u32x4v*)(lds + ML_KS + r * QROW + c * 16) = pk[i]; } \
        if (tid < 256) { const int r = tid >> 2, c = tid & 3; *(LAS u32x4v*)(lds + ML_VS + r * VROW + c * 16) = pv; \
            const float wk_ = exp_(pgr_a - fmaxf(mp_, pgl_cm)); u32x4v sv; \
            sv.x = pk2(bflo(pv.x) * wk_, bfhi(pv.x) * wk_); sv.y = pk2(bflo(pv.y) * wk_, bfhi(pv.y) * wk_); sv.z = pk2(bflo(pv.z) * wk_, bfhi(pv.z) * wk_); sv.w = pk2(bflo(pv.w) * wk_, bfhi(pv.w) * wk_); \
            *(LAS u32x4v*)(lds + ML_VW + r * VROW + c * 16) = sv; } \
        if (w == 0) { const float M_ = fmaxf(mp_, pg[2]); const float ML_ = __shfl(M_, 63); \
            aS[lane] = pg[1]; MS_[lane] = M_; emS[lane] = exp_(-(pg[0] + M_)); wkS[lane] = exp_(pg[1] - ML_); wiS[lane] = exp_(mp_ - M_); \
            if (lane == 0) scS[0] = exp_(mp_ - ML_); } } while (0)
    __syncthreads();
    ML_PREFETCH(0);
    ML_COMMIT(0);
    for (int ck = 0; ck < 64; ++ck) {
        const int t0 = ck * 64;
        ML_BAR();
        if (ck + 1 < 64) ML_PREFETCH(ck + 1);
        const int t = 16 * mt + fr;
        bf16x8m af[8];
        {
            const int ntb = (w & 1) * 2;
#pragma unroll
            for (int ks = 0; ks < 8; ++ks) af[ks] = *(const LAS bf16x8m*)(lds + ML_QS + (16 * mt + fr) * QROW + (32 * ks + 8 * fq) * 2);
            const float Mt = MS_[t];
            float as_[2][4];
#pragma unroll
            for (int nn = 0; nn < 2; ++nn)
#pragma unroll
                for (int i = 0; i < 4; ++i) as_[nn][i] = aS[16 * (ntb + nn) + 4 * fq + i];
            float qd = 0.f;
            {
                const int tt = tid >> 3, part = tid & 7;
#pragma unroll
                for (int c = 0; c < 4; ++c) { const u32x4v qv = *(const LAS u32x4v*)(lds + ML_QS + tt * QROW + (32 * part + 8 * c) * 2);
                    const f32x4v n0 = *(const LAS f32x4v*)(nS + 32 * part + 8 * c), n1 = *(const LAS f32x4v*)(nS + 32 * part + 8 * c + 4);
                    qd += bflo(qv.x) * n0[0] + bfhi(qv.x) * n0[1] + bflo(qv.y) * n0[2] + bfhi(qv.y) * n0[3] + bflo(qv.z) * n1[0] + bfhi(qv.z) * n1[1] + bflo(qv.w) * n1[2] + bfhi(qv.w) * n1[3]; }
            }
            __builtin_amdgcn_sched_barrier(0);
#pragma unroll
            for (int nn = 0; nn < 2; ++nn) {
                const int nt = ntb + nn;
                pg8::f32x4 acc = (pg8::f32x4){0.f, 0.f, 0.f, 0.f};
                float rsum = 0.f;
                if (nt <= mt) {
                    bf16x8m bfr[8];
#pragma unroll
                    for (int ks = 0; ks < 8; ++ks) bfr[ks] = *(const LAS bf16x8m*)(lds + ML_KS + (16 * nt + fr) * QROW + (32 * ks + 8 * fq) * 2);
                    __builtin_amdgcn_sched_barrier(0);
#pragma unroll
                    for (int ks = 0; ks < 8; ++ks) acc = MFMA16(bfr[ks], af[ks], acc);
#pragma unroll
                    for (int i = 0; i < 4; ++i) { const int s = 16 * nt + 4 * fq + i; const float p = (s <= t) ? acc[i] * exp_(as_[nn][i] - Mt) : 0.f; acc[i] = p; rsum += p; }
                }
                rsum = sum_x32(sum_x16(rsum));
                if (fq == 0) rsS[t * 4 + nt] = rsum;
                u32x2v pw; pw.x = pk2(acc[0], acc[1]); pw.y = pk2(acc[2], acc[3]);
                *(LAS u32x2v*)(lds + ML_PS + t * PROW + (16 * nt + 4 * fq) * 2) = pw;
            }
            qd = sum_grp8(qd);
            if ((tid & 7) == 0) qnS[tid >> 3] = qd;
        }
        ML_BAR();
        const int dt = w & 1;
        bf16x8m pa[2], vb[2], cb[8];
#pragma unroll
        for (int ks = 0; ks < 2; ++ks) {
            pa[ks] = *(const LAS bf16x8m*)(lds + ML_PS + (16 * mt + fr) * PROW + (32 * ks + 8 * fq) * 2);
            { const v4i16_t lo = ldtr(lds + ML_VS + 32 * ks * VROW + trv + 32 * dt), hi = ldtr(lds + ML_VS + (32 * ks + 4) * VROW + trv + 32 * dt); vb[ks] = __builtin_shufflevector(lo, hi, 0, 1, 2, 3, 4, 5, 6, 7); }
        }
#pragma unroll
        for (int ks = 0; ks < 8; ++ks) cb[ks] = *(const LAS bf16x8m*)(lds + ML_CT + (16 * dt + fr) * QROW + (32 * ks + 8 * fq) * 2);
        const float decay = scS[0];
        const float wi = wiS[t];
        const float den = (rsS[t * 4] + rsS[t * 4 + 1]) + (rsS[t * 4 + 2] + rsS[t * 4 + 3]) + wi * qnS[t];
        const float dn = fmaxf(fabsf(den), emS[t]);
        float npart[8];
        {
            const int dk8 = tid & 31, sl = tid >> 5;
#pragma unroll
            for (int j = 0; j < 8; ++j) npart[j] = 0.f;
#pragma unroll
            for (int r = 0; r < 4; ++r) { const u32x4v kv = *(const LAS u32x4v*)(lds + ML_KS + (4 * sl + r) * QROW + dk8 * 16); const float wkr = wkS[4 * sl + r];
                npart[0] += wkr * bflo(kv.x); npart[1] += wkr * bfhi(kv.x); npart[2] += wkr * bflo(kv.y); npart[3] += wkr * bfhi(kv.y);
                npart[4] += wkr * bflo(kv.z); npart[5] += wkr * bfhi(kv.z); npart[6] += wkr * bflo(kv.w); npart[7] += wkr * bfhi(kv.w); }
            *(LAS f32x4v*)(lds + ML_NPT + (sl * 256 + dk8 * 8) * 4) = (f32x4v){npart[0], npart[1], npart[2], npart[3]};
            *(LAS f32x4v*)(lds + ML_NPT + (sl * 256 + dk8 * 8 + 4) * 4) = (f32x4v){npart[4], npart[5], npart[6], npart[7]};
        }
        __builtin_amdgcn_sched_barrier(0);
        {
            pg8::f32x4 acc1 = (pg8::f32x4){0.f, 0.f, 0.f, 0.f}, acc2 = (pg8::f32x4){0.f, 0.f, 0.f, 0.f};
#pragma unroll
            for (int ks = 0; ks < 2; ++ks) acc1 = MFMA16(vb[ks], pa[ks], acc1);
#pragma unroll
            for (int ks = 0; ks < 8; ++ks) acc2 = MFMA16(cb[ks], af[ks], acc2);
            bf16x8m va[2][2], kb[2][2];
#pragma unroll
            for (int ks = 0; ks < 2; ++ks) {
#pragma unroll
                for (int dvt = 0; dvt < 2; ++dvt) { const v4i16_t lo = ldtr(lds + ML_VW + 32 * ks * VROW + trv + 32 * dvt), hi = ldtr(lds + ML_VW + (32 * ks + 4) * VROW + trv + 32 * dvt); va[dvt][ks] = __builtin_shufflevector(lo, hi, 0, 1, 2, 3, 4, 5, 6, 7); }
#pragma unroll
                for (int nk = 0; nk < 2; ++nk) { const v4i16_t lo = ldtr(lds + ML_KS + 32 * ks * QROW + trk + 32 * (2 * w + nk)), hi = ldtr(lds + ML_KS + (32 * ks + 4) * QROW + trk + 32 * (2 * w + nk)); kb[nk][ks] = __builtin_shufflevector(lo, hi, 0, 1, 2, 3, 4, 5, 6, 7); }
            }
#pragma unroll
            for (int dvt = 0; dvt < 2; ++dvt)
#pragma unroll
                for (int nk = 0; nk < 2; ++nk) {
                    pg8::f32x4 c = Cacc[dvt][nk] * decay;
#pragma unroll
                    for (int ks = 0; ks < 2; ++ks) c = MFMA16(kb[nk][ks], va[dvt][ks], c);
                    Cacc[dvt][nk] = c;
                }
            const float inv = __builtin_amdgcn_rcpf(dn);
            float hv[4]; float sq = 0.f;
#pragma unroll
            for (int i = 0; i < 4; ++i) { hv[i] = (acc1[i] + wi * acc2[i]) * inv; sq += hv[i] * hv[i]; }
            u32x2v hw; hw.x = pk2(hv[0], hv[1]); hw.y = pk2(hv[2], hv[3]);
            *(u32x2v*)(HB + (size_t)(t0 + t) * DM + 16 * dt + 4 * fq) = hw;
            sq = sum_x32(sum_x16(sq));
            if (fq == 0) SSQ[(size_t)(t0 + t) * 64 + dt] = sq;
        }
        ML_BAR();
#pragma unroll
        for (int dvt = 0; dvt < 2; ++dvt)
#pragma unroll
            for (int nk = 0; nk < 2; ++nk) { u32x2v cw; cw.x = pk2(Cacc[dvt][nk][0], Cacc[dvt][nk][1]); cw.y = pk2(Cacc[dvt][nk][2], Cacc[dvt][nk][3]);
                *(LAS u32x2v*)(lds + ML_CT + (16 * dvt + fr) * QROW + (16 * (2 * w + nk) + 4 * fq) * 2) = cw; }
        if (tid < 256) { float pv_[16];
#pragma unroll
            for (int sl = 0; sl < 16; ++sl) pv_[sl] = *(const LAS float*)(lds + ML_NPT + (sl * 256 + tid) * 4);
            const float nold = nS[tid];
            __builtin_amdgcn_sched_barrier(0);
            float s = 0.f;
#pragma unroll
            for (int sl = 0; sl < 16; ++sl) s += pv_[sl];
            nS[tid] = decay * nold + s; }
        if (ck + 1 < 64) ML_COMMIT(ck + 1);
    }
#undef ML_PREFETCH
#undef ML_COMMIT
#undef ML_BAR
    __syncthreads();
    {
        float* Cout = P.out + O_C_P + (size_t)(b * 4 + h) * 65536 + dvs * 32;
#pragma unroll
        for (int dvt = 0; dvt < 2; ++dvt)
#pragma unroll
            for (int nk = 0; nk < 2; ++nk)
#pragma unroll
                for (int i = 0; i < 4; ++i) Cout[(size_t)(16 * (2 * w + nk) + 4 * fq + i) * 256 + 16 * dvt + fr] = Cacc[dvt][nk][i];
        if (dvs == 0) { if (tid < 256) P.out[O_N_P + (size_t)(b * 4 + h) * 256 + tid] = nS[tid]; if (tid == 0) P.out[O_M_P + b * 4 + h] = mpS[64]; }
    }
    __syncthreads();
}

__device__ __forceinline__ void sample_mlstm_unit(const Params& P, LAS unsigned char* lds, int unit) {
    const int tid = tid_fresh(), lane = tid & 63, w = tid >> 6;
    const int b = unit >> 2, h = unit & 3;
    unsigned char* ws = P.ws;
    const size_t row = (size_t)MP + b;
    const bf16* Z = (const bf16*)(ws + WS_Z) + row * NZ;
    LAS float* qS = (LAS float*)lds; LAS float* kS = qS + 256; LAS float* vS = kS + 256; LAS float* red = vS + 256; LAS float* misc = red + 8 * 256;
    const float* sconv = P.in[5] + (size_t)b * 3 * 2048; const float* cw = P.in[13]; const float* cb = P.in[14];
    {
        const int j = tid & 255, col = (tid >> 8) * 1024 + h * 256 + j;
        float y = cb[col] + cw[col] * sconv[col] + cw[2048 + col] * sconv[2048 + col] + cw[2 * 2048 + col] * sconv[2 * 2048 + col] + cw[3 * 2048 + col] * bf2f(Z[ZMQ + col]);
        y = y * sigmoidf_(y);
        if (tid < 256) { qS[j] = y; vS[j] = bf2f(Z[ZMV + h * 256 + j]); } else kS[j] = y * 0.0625f;
    }
    const float* GT = (const float*)(ws + WS_GATES) + row * 8;
    const float ig = GT[h], lf = GT[4 + h], m0 = P.in[8][b * 4 + h];
    const float a = ig - lf, M = fmaxf(m0, a), m_new = lf + M, wk = exp_(a - M), decay = exp_(m0 - M);
    const float* n0 = P.in[7] + (size_t)(b * 4 + h) * 256;
    __syncthreads();
    float qk = 0.f, qn = 0.f;
#pragma unroll
    for (int c = 0; c < 4; ++c) { const int j = lane + 64 * c; qk += qS[j] * kS[j]; qn += qS[j] * n0[j]; }
    qk = wave_sum(qk); qn = wave_sum(qn);
    {
        const float* C0 = P.in[6] + (size_t)(b * 4 + h) * 65536; float* C1 = P.out + O_C_S + (size_t)(b * 4 + h) * 65536;
        const int c4 = lane * 4;
        const f32x4v v4 = *(const LAS f32x4v*)(vS + c4);
        f32x4v acc = (f32x4v){0.f, 0.f, 0.f, 0.f};
#pragma unroll 4
        for (int r = 0; r < 32; ++r) {
            const int dk = w * 32 + r;
            const f32x4v c0 = *(const f32x4v*)(C0 + (size_t)dk * 256 + c4);
            acc = acc + c0 * qS[dk];
            *(f32x4v*)(C1 + (size_t)dk * 256 + c4) = c0 * decay + v4 * (wk * kS[dk]);
        }
        *(LAS f32x4v*)(red + w * 256 + c4) = acc;
    }
    __syncthreads();
    float hval = 0.f;
    if (tid < 256) {
        float qc = 0.f;
#pragma unroll
        for (int r = 0; r < 8; ++r) qc += red[r * 256 + tid];
        const float num = qk * wk * vS[tid] + decay * qc, den = qk * wk + decay * qn;
        hval = num / fmaxf(fabsf(den), exp_(-m_new));
        const float s = wave_sum(hval * hval);
        if (lane == 0) misc[w] = s;
        P.out[O_N_S + (size_t)(b * 4 + h) * 256 + tid] = decay * n0[tid] + wk * kS[tid];
        if (tid == 0) P.out[O_M_S + b * 4 + h] = m_new;
    }
    __syncthreads();
    if (tid < 256) {
        const float ssq = (misc[0] + misc[1]) + (misc[2] + misc[3]);
        const float hm = hval * __builtin_amdgcn_rsqf(ssq * (1.0f / 256.0f) + EPSN) * P.in[17][h * 256 + tid];
        ((bf16*)(ws + WS_SOB))[(size_t)b * 1024 + h * 256 + tid] = (bf16)f2bf(hm * sigmoidf_(bf2f(Z[ZMO + h * 256 + tid])));
    }
    __syncthreads();
}

template <int W> __device__ __forceinline__ void shift_copy(const float* __restrict__ src, float* __restrict__ dst, int wb, int nwb) {
    constexpr unsigned per_b = (unsigned)(W - 1) * 128u, total = 32u * per_b;
    const f32x4v* s4 = (const f32x4v*)src; f32x4v* d4 = (f32x4v*)dst;
    const unsigned tid = (unsigned)tid_fresh();
    for (unsigned e0 = (unsigned)wb * 4096u + tid; e0 < total; e0 += (unsigned)nwb * 4096u) {
        f32x4v v[8]; unsigned off[8];
#pragma unroll
        for (int u = 0; u < 8; ++u) { const unsigned e = e0 + 512u * u; const unsigned b = e / per_b, x = e - b * per_b; off[u] = b * (unsigned)(W * 128) + x;
            if (e < total) v[u] = __builtin_nontemporal_load(s4 + off[u] + 128); }
#pragma unroll
        for (int u = 0; u < 8; ++u) { const unsigned e = e0 + 512u * u; if (e < total) __builtin_nontemporal_store(v[u], d4 + off[u]); }
    }
}

__device__ __forceinline__ void phase2b(const Params& P, LAS unsigned char* lds, int G) {
    const int nm = G >= 256 ? 128 : (G / 2 > 0 ? G / 2 : 1);
    if ((int)blockIdx.x < nm) {
#pragma nounroll
        for (int rep = 0, nrep = opaque_s(REP_ML); rep < nrep; ++rep)
            for (int u = blockIdx.x; u < 128; u += nm) mlstm_unit(P, lds, nm == 128 ? ((((u & 7) * 2 + (u >> 6)) << 3) | ((u >> 3) & 7)) : u);
    }
    if (G == 1 || (int)blockIdx.x >= nm) {
        const int wb = G == 1 ? 0 : blockIdx.x - nm, nwb = G == 1 ? 1 : G - nm;
#pragma nounroll
        for (int rep = 0, nrep = opaque_s(REP_CP); rep < nrep; ++rep) {
            attention_work(P, lds, wb * 8 + (tid_fresh() >> 6), nwb * 8);
            __syncthreads();
            for (int u = wb; u < 128; u += nwb) sample_mlstm_unit(P, lds, u);
            convert_weights(P, lds, wb * 8 + (tid_fresh() >> 6), nwb * 8, 16 * 264, W_ITEMS_ALL);
            __syncthreads();
            shift_copy<128>(P.in[2], P.out + O_KV128_S, wb, nwb);
            shift_copy<512>(P.in[3], P.out + O_KV512_S, wb, nwb);
            shift_copy<2048>(P.in[4], P.out + O_KV2048_S, wb, nwb);
        }
    }
}

__device__ __forceinline__ void phase_e2(const Params& P, int G) {
    unsigned char* ws = P.ws; const int tid = tid_fresh();
    const bf16* OG = (const bf16*)(ws + WS_OG); const float* LSE = (const float*)(ws + WS_LSE); bf16* OAB = (bf16*)(ws + WS_QK);
    for (int idx = blockIdx.x * 512 + tid; idx < MT * 32; idx += G * 512) {
        const int row = idx >> 5, c = (idx & 31) * 8, h = c >> 6;
        const float l0 = LSE[((size_t)0 * MPAD + row) * 4 + h], l1 = LSE[((size_t)1 * MPAD + row) * 4 + h], l2 = LSE[((size_t)2 * MPAD + row) * 4 + h];
        const float mx = fmaxf(l0, fmaxf(l1, l2)); float w0 = exp_(l0 - mx), w1 = exp_(l1 - mx), w2 = exp_(l2 - mx); const float inv = 1.0f / (w0 + w1 + w2); w0 *= inv; w1 *= inv; w2 *= inv;
        const u32x4v a = *(const u32x4v*)(OG + ((size_t)0 * MPAD + row) * 256 + c), bq = *(const u32x4v*)(OG + ((size_t)1 * MPAD + row) * 256 + c), cq = *(const u32x4v*)(OG + ((size_t)2 * MPAD + row) * 256 + c);
        u32x4v o;
        o.x = pk2(w0 * bflo(a.x) + w1 * bflo(bq.x) + w2 * bflo(cq.x), w0 * bfhi(a.x) + w1 * bfhi(bq.x) + w2 * bfhi(cq.x));
        o.y = pk2(w0 * bflo(a.y) + w1 * bflo(bq.y) + w2 * bflo(cq.y), w0 * bfhi(a.y) + w1 * bfhi(bq.y) + w2 * bfhi(cq.y));
        o.z = pk2(w0 * bflo(a.z) + w1 * bflo(bq.z) + w2 * bflo(cq.z), w0 * bfhi(a.z) + w1 * bfhi(bq.z) + w2 * bfhi(cq.z));
        o.w = pk2(w0 * bflo(a.w) + w1 * bflo(bq.w) + w2 * bflo(cq.w), w0 * bfhi(a.w) + w1 * bfhi(bq.w) + w2 * bfhi(cq.w));
        { const int k_ = (c & 63) >> 3, d0_ = 16 * (k_ & 1) + 4 * ((k_ >> 1) & 1) + 32 * (k_ >> 2); bf16* oo = OAB + (size_t)row * KMIX + (c & ~63) + d0_;
          u32x2v lo_; lo_.x = o.x; lo_.y = o.y; u32x2v hi_; hi_.x = o.z; hi_.y = o.w; *(u32x2v*)oo = lo_; *(u32x2v*)(oo + 8) = hi_; }
    }
    const bf16* HBm = (const bf16*)(ws + WS_HBUF); const float* SSQ = (const float*)(ws + WS_SSQ); const bf16* Z = (const bf16*)(ws + WS_Z); const float* mh = P.in[17];
    for (int idx = blockIdx.x * 512 + tid; idx < MP * 64; idx += G * 512) {
        const int row = idx >> 6, c0 = (idx & 63) * 16, h = c0 >> 8;
        const f32x4v* sp = (const f32x4v*)(SSQ + ((size_t)row * 4 + h) * 16);
        const f32x4v s0 = sp[0], s1 = sp[1], s2 = sp[2], s3 = sp[3];
        u32x4v hv[2], zo[2]; f32x4v g0[2], g1[2];
#pragma unroll
        for (int q = 0; q < 2; ++q) { const int c = c0 + 8 * q; hv[q] = *(const u32x4v*)(HBm + (size_t)row * DM + c); zo[q] = *(const u32x4v*)(Z + (size_t)row * NZ + ZMO + c); g0[q] = *(const f32x4v*)(mh + c); g1[q] = *(const f32x4v*)(mh + c + 4); }
        const float tot = ((s0[0] + s0[1]) + (s0[2] + s0[3])) + ((s1[0] + s1[1]) + (s1[2] + s1[3])) + ((s2[0] + s2[1]) + (s2[2] + s2[3])) + ((s3[0] + s3[1]) + (s3[2] + s3[3]));
        const float r = __builtin_amdgcn_rsqf(tot * (1.0f / 256.0f) + EPSN);
#pragma unroll
        for (int q = 0; q < 2; ++q) {
            u32x4v o;
            o.x = pk2(bflo(hv[q].x) * r * g0[q][0] * sigmoidf_(bflo(zo[q].x)), bfhi(hv[q].x) * r * g0[q][1] * sigmoidf_(bfhi(zo[q].x)));
            o.y = pk2(bflo(hv[q].y) * r * g0[q][2] * sigmoidf_(bflo(zo[q].y)), bfhi(hv[q].y) * r * g0[q][3] * sigmoidf_(bfhi(zo[q].y)));
            o.z = pk2(bflo(hv[q].z) * r * g1[q][0] * sigmoidf_(bflo(zo[q].z)), bfhi(hv[q].z) * r * g1[q][1] * sigmoidf_(bfhi(zo[q].z)));
            o.w = pk2(bflo(hv[q].w) * r * g1[q][2] * sigmoidf_(bflo(zo[q].w)), bfhi(hv[q].w) * r * g1[q][3] * sigmoidf_(bfhi(zo[q].w)));
            *(u32x4v*)(OAB + (size_t)row * KMIX + 256 + c0 + 8 * q) = o;
        }
    }
    const bf16* SOB = (const bf16*)(ws + WS_SOB);
    for (int idx = blockIdx.x * 512 + tid; idx < MS * 128; idx += G * 512) { const int b = idx >> 7, c = (idx & 127) * 8; *(u32x4v*)(OAB + (size_t)(MP + b) * KMIX + 256 + c) = *(const u32x4v*)(SOB + (size_t)b * 1024 + c); }
}

__device__ __forceinline__ void phase8(const Params& P, int G) {
    unsigned char* ws = P.ws; const int tid = tid_fresh();
    const bf16* H3 = (const bf16*)(ws + WS_XN); const float* ss3 = (const float*)(ws + WS_SS3); const float* nf = P.in[28];
    for (int idx = blockIdx.x * 512 + tid; idx < MT * 64; idx += G * 512) {
        const int row = idx >> 6, c0 = (idx & 63) * 16;
        const float rs = pg8::row_rs(ss3, row);
        u32x4v hv[2]; f32x4v g0[2], g1[2];
#pragma unroll
        for (int q = 0; q < 2; ++q) { const int c = c0 + 8 * q; hv[q] = *(const u32x4v*)(H3 + (size_t)row * DM + c); g0[q] = *(const f32x4v*)(nf + c); g1[q] = *(const f32x4v*)(nf + c + 4); }
        float* dst = row < MP ? P.out + O_Y_P + (size_t)row * DM + c0 : P.out + O_Y_S + (size_t)(row - MP) * DM + c0;
#pragma unroll
        for (int q = 0; q < 2; ++q) {
            *(f32x4v*)(dst + 8 * q) = (f32x4v){bflo(hv[q].x) * rs * g0[q][0], bfhi(hv[q].x) * rs * g0[q][1], bflo(hv[q].y) * rs * g0[q][2], bfhi(hv[q].y) * rs * g0[q][3]};
            *(f32x4v*)(dst + 8 * q + 4) = (f32x4v){bflo(hv[q].z) * rs * g1[q][0], bfhi(hv[q].z) * rs * g1[q][1], bflo(hv[q].w) * rs * g1[q][2], bfhi(hv[q].w) * rs * g1[q][3]};
        }
    }
}

__device__ __forceinline__ float thin_dot(const bf16* __restrict__ a, const bf16* __restrict__ b, int kq) {
    float s0 = 0.f, s1 = 0.f;
#pragma unroll 4
    for (int k = 0; k < kq; k += 8) {
        const u32x4v x = *(const u32x4v*)(a + k), y = *(const u32x4v*)(b + k);
        s0 += bflo(x.x) * bflo(y.x) + bflo(x.y) * bflo(y.y) + bflo(x.z) * bflo(y.z) + bflo(x.w) * bflo(y.w);
        s1 += bfhi(x.x) * bfhi(y.x) + bfhi(x.y) * bfhi(y.y) + bfhi(x.z) * bfhi(y.z) + bfhi(x.w) * bfhi(y.w);
    }
    float s = s0 + s1;
    s += __shfl_xor(s, 1); s += __shfl_xor(s, 2);
    return s;
}
__device__ __forceinline__ void thin_phase(const Params& P, int which, int G) {
    unsigned char* ws = P.ws;
    const int tid = tid_fresh(), r = tid >> 4, c = (tid >> 2) & 3, kq = tid & 3;
    const size_t row = (size_t)MP + r;
    const bf16* Z = (const bf16*)(ws + WS_Z); bf16* HBb = (bf16*)(ws + WS_HBUF);
    for (int col = blockIdx.x * 4 + c; col < DM; col += G * 4) {
        if (which == 3) {
            const bf16* oab = (const bf16*)(ws + WS_QK) + row * KMIX;
            const float dA = thin_dot(oab + kq * 64, (const bf16*)(ws + WS_WA) + (size_t)col * KMIX + kq * 64, 64);
            const float dB = thin_dot(oab + 256 + kq * 256, (const bf16*)(ws + WS_WA) + (size_t)col * KMIX + 256 + kq * 256, 256);
            if (kq == 0) ((bf16*)(ws + WS_XN))[row * DM + col] = (bf16)f2bf(sigmoidf_(bf2f(Z[row * NZ + ZGA + col])) * dA + sigmoidf_(bf2f(Z[row * NZ + ZGB + col])) * dB);
        } else if (which == 4 || which == 6) {
            float dd, base; float* ss;
            if (which == 4) { dd = thin_dot((const bf16*)(ws + WS_XN) + row * DM + kq * 256, (const bf16*)(ws + WS_WO) + (size_t)col * DM + kq * 256, 256); base = P.in[1][(size_t)r * DM + col]; ss = (float*)(ws + WS_SS1); }
            else { dd = thin_dot((const bf16*)(ws + WS_ACT) + row * DFF + kq * 704, (const bf16*)(ws + WS_WD) + (size_t)col * DFF + kq * 704, 704); base = bf2f(HBb[row * DM + col]); ss = (float*)(ws + WS_SS2); }
            const float hv = base + dd;
            float sq = hv * hv; sq += __shfl_xor(sq, 4); sq += __shfl_xor(sq, 8);
            if (kq == 0) { HBb[row * DM + col] = (bf16)f2bf(hv); if (c == 0) atomicAdd(ss + row * 16, sq); }
        } else {
            const float dp = thin_dot((const bf16*)(ws + WS_PB) + row * 256 + kq * 64, (const bf16*)(ws + WS_WPP) + (size_t)col * 256 + kq * 64, 64);
            const float dg = thin_dot(HBb + row * DM + kq * 256, (const bf16*)(ws + WS_WPG) + (size_t)col * DM + kq * 256, 256);
            const float rs = pg8::row_rs((const float*)(ws + WS_SS2), (int)row);
            const float hv = bf2f(HBb[row * DM + col]) + sigmoidf_(rs * dg) * dp;
            float sq = hv * hv; sq += __shfl_xor(sq, 4); sq += __shfl_xor(sq, 8);
            if (kq == 0) { ((bf16*)(ws + WS_XN))[row * DM + col] = (bf16)f2bf(hv); if (c == 0) atomicAdd((float*)(ws + WS_SS3) + row * 16, sq); }
        }
    }
}

__global__ void __launch_bounds__(512) hybrid_step_fwd(Params P) {
    extern __shared__ __attribute__((aligned(16))) unsigned char lds_raw[];
    LAS unsigned char* lds = (LAS unsigned char*)lds_raw;
    cg::grid_group grid = cg::this_grid();
    const int G = gridDim.x;
    unsigned char* ws = P.ws;
    unsigned* barw = (unsigned*)(ws + WS_BAR);
    volatile LAS unsigned* xst = (volatile LAS unsigned*)(lds + LDS_BYTES - 64);
    { const int t0_ = tid_fresh(); if (t0_ < 2) xst[t0_] = 0u; if (blockIdx.x == 0) for (int i = t0_; i < XCD_BAR_WORDS; i += 512) barw[i] = 0u; }
#pragma nounroll
    for (int rep = 0, nrep = opaque_s(REP_P0); rep < nrep; ++rep) {
        phase0(P, lds, G);
        grid.sync();
    }
    const XcdBarrier xb = xcd_barrier_post(barw, xst);
#define GSYNC() do { _Pragma("nounroll") for (int r_ = 0, nr_ = opaque_s(REP_SYNC); r_ < nr_; ++r_) xcd_barrier(xb); } while (0)
#pragma nounroll
    for (int rep = 0, nrep = opaque_s(REP_P1); rep < nrep; ++rep) {
        pg8::Gemm g{(const bf16*)(ws + WS_XN), (const bf16*)(ws + WS_WIN), MPAD, NZ, DM, DM, DM}; pg8::StaticOrder S; S.init(MPAD, NZ, G, (int)blockIdx.x);
        pg8::EpiZ E{(bf16*)(ws + WS_Z), (bf16*)(ws + WS_VT), (const float*)(ws + WS_ROPE), P.out};
        pg8::gemm_phase<pg8::EpiZ, pg8::StaticOrder, true, true>(lds, g, S, E);
        GSYNC();
    }
#pragma nounroll
    for (int rep = 0, nrep = opaque_s(REP_P2A); rep < nrep; ++rep) {
        phase2a(P, lds, G);
        GSYNC();
    }
#pragma nounroll
    for (int rep = 0, nrep = opaque_s(REP_P2B); rep < nrep; ++rep) {
        phase2b(P, lds, G);
        GSYNC();
    }
#pragma nounroll
    for (int rep = 0, nrep = opaque_s(REP_E2); rep < nrep; ++rep) {
        phase_e2(P, G);
        GSYNC();
    }
#pragma nounroll
    for (int rep = 0, nrep = opaque_s(REP_P3); rep < nrep; ++rep) {
        pg8::StaticOrder S; S.init(MP, DM, G, (int)blockIdx.x);
        pg8::Gemm g{(const bf16*)(ws + WS_QK), (const bf16*)(ws + WS_WA), MP, DM, KMIX, KMIX, KMIX};
        pg8::EpiMix E{(const bf16*)(ws + WS_Z), (bf16*)(ws + WS_XN)};
        pg8::gemm_phase<pg8::EpiMix, pg8::StaticOrder, true, true>(lds, g, S, E);
        thin_phase(P, 3, G);
        GSYNC();
    }
#pragma nounroll
    for (int rep = 0, nrep = opaque_s(REP_P4); rep < nrep; ++rep) {
        pg8::StaticOrder S; S.init(MP, DM, G, (int)blockIdx.x);
        pg8::Gemm g{(const bf16*)(ws + WS_XN), (const bf16*)(ws + WS_WO), MP, DM, DM, DM, DM};
        pg8::EpiRes E{P.in[0], (bf16*)(ws + WS_HBUF), (float*)(ws + WS_SS1), 0};
        pg8::gemm_phase<pg8::EpiRes, pg8::StaticOrder, true, true>(lds, g, S, E);
        thin_phase(P, 4, G);
        GSYNC();
    }
#pragma nounroll
    for (int rep = 0, nrep = opaque_s(REP_P5); rep < nrep; ++rep) {
        pg8::StaticOrder S; S.init(MPAD, NGU, G, (int)blockIdx.x);
        pg8::Gemm g{(const bf16*)(ws + WS_HBUF), (const bf16*)(ws + WS_WGU), MPAD, NGU, DM, DM, DM};
        pg8::EpiGU E{(const float*)(ws + WS_SS1), (bf16*)(ws + WS_ACT)};
        pg8::gemm_phase<pg8::EpiGU, pg8::StaticOrder, true, true>(lds, g, S, E);
        GSYNC();
    }
    {
        pg8::StaticOrder S; S.init(MP, DM, G, (int)blockIdx.x);
        pg8::Gemm g{(const bf16*)(ws + WS_ACT), (const bf16*)(ws + WS_WD), MP, DM, DFF, DFF, DFF};
        pg8::EpiRes E{nullptr, (bf16*)(ws + WS_HBUF), (float*)(ws + WS_SS2), 1};
        pg8::gemm_phase<pg8::EpiRes, pg8::StaticOrder, true, true>(lds, g, S, E);
        thin_phase(P, 6, G);
        GSYNC();
    }
    {
        pg8::StaticOrder S; S.init(MP, DM, G, (int)blockIdx.x);
#pragma nounroll
        for (int pass = 0; pass < 2; ++pass) {
            int ps = pass; asm volatile("" : "+s"(ps));
            pg8::Gemm g{(const bf16*)(ws + (ps ? WS_HBUF : WS_PB)), (const bf16*)(ws + (ps ? WS_WPG : WS_WPP)), MP, DM, ps ? DM : 256, ps ? DM : 256, ps ? DM : 256};
            pg8::EpiPle E{(const float*)(ws + WS_SS2), (bf16*)(ws + WS_PP), (const bf16*)(ws + WS_HBUF), (bf16*)(ws + WS_XN), (float*)(ws + WS_SS3), ps};
            pg8::gemm_phase<pg8::EpiPle, pg8::StaticOrder, true, true>(lds, g, S, E);
        }
        thin_phase(P, 7, G);
        GSYNC();
    }
#pragma nounroll
    for (int rep = 0, nrep = opaque_s(REP_P8); rep < nrep; ++rep) phase8(P, G);
}

extern "C" void kernel_launch(void* const* d_in, const int* in_sizes, int n_in, void* d_out, int out_size, void* d_ws, size_t ws_size, hipStream_t stream) {
    static int grid_blocks = 0;
    if (!grid_blocks) {
        int dev = 0, cus = 0, per_cu = 0;
        (void)hipGetDevice(&dev);
        (void)hipDeviceGetAttribute(&cus, hipDeviceAttributeMultiprocessorCount, dev);
        (void)hipFuncSetAttribute((const void*)hybrid_step_fwd, hipFuncAttributeMaxDynamicSharedMemorySize, LDS_BYTES);
        (void)hipOccupancyMaxActiveBlocksPerMultiprocessor(&per_cu, (const void*)hybrid_step_fwd, 512, LDS_BYTES);
        if (per_cu < 1) per_cu = 1;
        grid_blocks = cus * per_cu;
        if (n_in != 29 || (size_t)out_size != O_END || ws_size < WS_END) { fprintf(stderr, "kernel_launch: unexpected sizes n_in %d out %d ws %zu (need %zu)\n", n_in, out_size, ws_size, (size_t)WS_END); grid_blocks = -1; }
    }
    if (grid_blocks < 0) return;
    Params p{};
    for (int i = 0; i < 29; ++i) p.in[i] = (const float*)d_in[i];
    p.out = (float*)d_out; p.ws = (unsigned char*)d_ws;
    void* args[] = {&p};
    hipError_t e = hipLaunchCooperativeKernel((void*)hybrid_step_fwd, dim3(grid_blocks), dim3(512), args, LDS_BYTES, stream);
    if (e != hipSuccess) fprintf(stderr, "cooperative launch failed: %s (grid %d)\n", hipGetErrorString(e), grid_blocks);
}
```
